# Optimizing an MI355X kernel written in HIP

```python
import math
import jax, jax.numpy as jnp
from jax import lax
import numpy as np

D_MODEL = 1024
BATCH = 16
SEQ = 2048
DEPTH = 2
DEC_BATCH = 32
DEC_SEQ = 8
PAST_LEN = 16384
PAGE_SIZE = 128

NORM_EPS = 1e-6
N_MOD = 9
D_FF = 2816
A_GROUPS = ((128, 1), (512, 4), (2048, 16))
A_N_GROUPS = 3
A_HEADS = 8
A_HEAD_DIM = 64
A_WIDTH = A_HEADS * A_HEAD_DIM
A_KEYS = 128
A_BLOCK = 128
REL_BUCKETS = 32
REL_MAX_EXACT = 16
REL_MAX_DISTANCE = 2048
B_WIDTH = 1024
B_HEAD_DIM = 64
B_HEADS = B_WIDTH // B_HEAD_DIM
B_GROUPS = 2
B_STATE = 128
B_CONV = 4
B_CONV_CH = B_WIDTH + 2 * B_GROUPS * B_STATE
B_CHUNK = 128
C_WIDTH = 1024
C_BLOCKS = 8
C_BLOCK_DIM = C_WIDTH // C_BLOCKS
C_CONV = 4
C_POW = 8.0
IN_SPLIT = (A_N_GROUPS * A_WIDTH, A_N_GROUPS * A_WIDTH, A_N_GROUPS * A_WIDTH,
            B_WIDTH, B_CONV_CH, B_HEADS, C_WIDTH, C_WIDTH, 3 * D_MODEL)
N_IN = 3 * A_N_GROUPS * A_WIDTH + B_WIDTH + B_CONV_CH + B_HEADS + 2 * C_WIDTH + 3 * D_MODEL

kernel_name = "hybrid_gated_dilated_ssd_lru_decoder_step"


def rmsnorm(x, g):
    x32 = x.astype(jnp.float32)
    y = x32 * lax.rsqrt(jnp.mean(x32 * x32, axis=-1, keepdims=True) + NORM_EPS)
    return (y * g.astype(jnp.float32)).astype(x.dtype)


def swiglu(h, w_in, w_out):
    u, v = jnp.split(h @ w_in, 2, axis=-1)
    return (jax.nn.silu(u) * v) @ w_out


def t5_bucket(dist):
    dist = np.asarray(dist)
    large = REL_MAX_EXACT + (np.log(np.maximum(dist, 1) / REL_MAX_EXACT)
                             / math.log(REL_MAX_DISTANCE / REL_MAX_EXACT)
                             * (REL_BUCKETS - REL_MAX_EXACT)).astype(np.int64)
    large = np.minimum(large, REL_BUCKETS - 1)
    return np.where(dist < REL_MAX_EXACT, dist, large).astype(np.int32)


def group_bias(rel_bias, g):
    dil = A_GROUPS[g][1]
    buckets = t5_bucket(np.arange(A_KEYS + 1) * dil)
    return rel_bias[buckets][:, g * A_HEADS:(g + 1) * A_HEADS].T.astype(jnp.float32)


def dilated_window_prompt(q, k, v, bias, dil):
    b, s, h, dh = q.shape
    m = s // dil
    mp = -(-m // A_BLOCK) * A_BLOCK
    nb = mp // A_BLOCK

    def strided(t):
        t = t.reshape(b, m, dil, h, dh).transpose(0, 2, 1, 3, 4).reshape(b * dil, m, h, dh)
        return jnp.pad(t, ((0, 0), (0, mp - m), (0, 0), (0, 0)))

    def band(t):
        tb = t.reshape(b * dil, nb, A_BLOCK, h, dh)
        prev = jnp.pad(tb, ((0, 0), (1, 0), (0, 0), (0, 0), (0, 0)))[:, :-1]
        return jnp.concatenate([prev, tb], axis=2)

    qb = strided(q).reshape(b * dil, nb, A_BLOCK, h, dh)
    kb, vb = band(strided(k)), band(strided(v))
    scores = jnp.einsum('bnqhd,bnkhd->bnhqk', qb, kb,
                        preferred_element_type=jnp.float32) * (A_HEAD_DIM ** -0.5)
    qi = np.arange(A_BLOCK)[:, None]
    kj = np.arange(2 * A_BLOCK)[None, :]
    dist = A_BLOCK + qi - kj
    valid = (dist >= 0) & (dist <= A_KEYS)
    first = valid & (kj >= A_BLOCK)
    valid_nb = np.concatenate([first[None], np.broadcast_to(valid, (nb - 1,) + valid.shape)], 0)
    bias_full = bias[:, np.clip(dist, 0, A_KEYS)]
    logits = jnp.where(valid_nb[None, :, None], scores + bias_full[None, None], -jnp.inf)
    lse = jax.nn.logsumexp(logits, axis=-1)
    p = jnp.exp(logits - lse[..., None])
    o = jnp.einsum('bnhqk,bnkhd->bnqhd', p.astype(vb.dtype), vb)
    o = o.reshape(b, dil, mp, h, dh)[:, :, :m].transpose(0, 2, 1, 3, 4).reshape(b, s, h, dh)
    lse = lse.transpose(0, 1, 3, 2).reshape(b, dil, mp, h)[:, :, :m]
    lse = lse.transpose(0, 2, 1, 3).reshape(b, s, h)
    return o, lse


def dilated_window_sample(q, k_new, v_new, kv_buf, bias, dil):
    b, t, h, dh = q.shape
    wb = kv_buf.shape[1]
    keys = jnp.concatenate([kv_buf[:, :, 0].astype(k_new.dtype), k_new], axis=1)
    vals = jnp.concatenate([kv_buf[:, :, 1].astype(v_new.dtype), v_new], axis=1)
    idx = wb + np.arange(t)[:, None] - dil * np.arange(A_KEYS + 1)[None, :]
    valid = idx >= 0
    idx = np.maximum(idx, 0)
    kg, vg = keys[:, idx], vals[:, idx]
    scores = jnp.einsum('bthd,btkhd->bhtk', q, kg,
                        preferred_element_type=jnp.float32) * (A_HEAD_DIM ** -0.5)
    logits = jnp.where(valid[None, None], scores + bias[:, None, :], -jnp.inf)
    lse = jax.nn.logsumexp(logits, axis=-1)
    p = jnp.exp(logits - lse[..., None])
    o = jnp.einsum('bhtk,btkhd->bthd', p.astype(vg.dtype), vg)
    return o, lse.transpose(0, 2, 1)


def causal_conv(u, buf, w, bias):
    kw = w.shape[0]
    full = jnp.concatenate([buf.astype(u.dtype), u], axis=1)
    out = lax.conv_general_dilated(full, w[:, None, :].astype(u.dtype), window_strides=(1,),
                                   padding='VALID', dimension_numbers=('NWC', 'WIO', 'NWC'),
                                   feature_group_count=u.shape[-1])
    return out + bias, full[:, full.shape[1] - (kw - 1):]


def ssd_scan(x, dt, a, bm, cm, h0):
    f32 = jnp.float32
    b, L, nh, p = x.shape
    g, n = bm.shape[2], bm.shape[3]
    r = nh // g
    q = B_CHUNK if L % B_CHUNK == 0 else L
    nc = L // q
    xr = x.astype(f32).reshape(b, nc, q, g, r, p)
    dtr = dt.reshape(b, nc, q, g, r)
    br = bm.astype(f32).reshape(b, nc, q, g, n)
    cr = cm.astype(f32).reshape(b, nc, q, g, n)
    acum = jnp.cumsum(dtr * a.reshape(g, r), axis=2)
    xdt = xr * dtr[..., None]
    causal = np.tril(np.ones((q, q), bool))[:, :, None, None]
    seg = acum[:, :, :, None] - acum[:, :, None, :]
    decay_ls = jnp.exp(jnp.where(causal, seg, -jnp.inf))
    cb = jnp.einsum('bclgn,bcsgn->bclsg', cr, br)
    y_diag = jnp.einsum('bclsgr,bcsgrp->bclgrp', cb[..., None] * decay_ls, xdt)
    to_end = jnp.exp(acum[:, :, -1:] - acum)
    chunk_states = jnp.einsum('bclgn,bclgrp->bcgrpn', br, xdt * to_end[..., None])
    chunk_decay = jnp.exp(acum[:, :, -1])

    def step(hc, inp):
        dec, st = inp
        return dec[..., None, None] * hc + st, hc

    h_last, h_in = lax.scan(step, h0.astype(f32).reshape(b, g, r, p, n),
                            (jnp.moveaxis(chunk_decay, 1, 0), jnp.moveaxis(chunk_states, 1, 0)))
    h_in = jnp.moveaxis(h_in, 0, 1)
    y_off = jnp.einsum('bclgn,bcgrpn->bclgrp', cr, h_in) * jnp.exp(acum)[..., None]
    y = (y_diag + y_off).reshape(b, L, nh, p)
    return y.astype(x.dtype), h_last.reshape(b, nh, p, n)


def rg_lru(xc, h0, w_r, b_r, w_i, b_i, lam):
    f32 = jnp.float32
    b, L, _ = xc.shape
    x32 = xc.astype(f32)
    xb = x32.reshape(b, L, C_BLOCKS, C_BLOCK_DIM)
    rg = jax.nn.sigmoid(jnp.einsum('blhi,hij->blhj', xb, w_r.astype(f32)).reshape(b, L, C_WIDTH) + b_r)
    ig = jax.nn.sigmoid(jnp.einsum('blhi,hij->blhj', xb, w_i.astype(f32)).reshape(b, L, C_WIDTH) + b_i)
    log_a = -C_POW * rg * jax.nn.softplus(-lam.astype(f32))
    a = jnp.exp(log_a)
    u = x32 * ig * jnp.sqrt(-jnp.expm1(2.0 * log_a))
    u = u.at[:, 0].add(a[:, 0] * h0.astype(f32))

    def comb(e1, e2):
        a1, b1 = e1
        a2, b2 = e2
        return a1 * a2, a2 * b1 + b2

    _, hs = lax.associative_scan(comb, (a, u), axis=1)
    return hs.astype(xc.dtype), hs[:, -1]


def mixer(h, lw, st, rel_bias, prompt):
    b, L, _ = h.shape
    f32 = jnp.float32
    offs = [int(o) for o in np.cumsum(IN_SPLIT)[:-1]]
    qa, ka, va, zb, xbc, dtb, xc, gc, gates = jnp.split(h @ lw['w_in'], offs, axis=-1)
    if prompt:
        conv_b0 = jnp.zeros((b, B_CONV - 1, B_CONV_CH), h.dtype)
        ssm0 = jnp.zeros((b, B_HEADS, B_HEAD_DIM, B_STATE), f32)
        conv_c0 = jnp.zeros((b, C_CONV - 1, C_WIDTH), h.dtype)
        lru0 = jnp.zeros((b, C_WIDTH), f32)
    else:
        conv_b0, ssm0, conv_c0, lru0 = st['conv_b'], st['ssm'], st['conv_c'], st['lru']
    shp = (b, L, A_N_GROUPS, A_HEADS, A_HEAD_DIM)
    qa, ka, va = qa.reshape(shp), ka.reshape(shp), va.reshape(shp)
    outs, lses, new_kv = [], [], []
    for g, (win, dil) in enumerate(A_GROUPS):
        bias = group_bias(rel_bias, g)
        if prompt:
            o, lse = dilated_window_prompt(qa[:, :, g], ka[:, :, g], va[:, :, g], bias, dil)
            keep = min(win, L)
            new_kv.append(jnp.stack([ka[:, L - keep:, g], va[:, L - keep:, g]], axis=2))
        else:
            o, lse = dilated_window_sample(qa[:, :, g], ka[:, :, g], va[:, :, g], st['kv'][g], bias, dil)
            new_kv.append(jnp.stack([ka[:, :, g], va[:, :, g]], axis=2))
        outs.append(o)
        lses.append(lse)
    wgt = jax.nn.softmax(jnp.stack(lses, 0), axis=0)
    oa = jnp.einsum('gblh,gblhd->blhd', wgt, jnp.stack(outs, 0).astype(f32))
    ya = oa.reshape(b, L, A_WIDTH).astype(h.dtype) @ lw['w_a_proj']
    xbc, conv_b_new = causal_conv(xbc, conv_b0, lw['conv_b_w'], lw['conv_b_b'])
    xbc = jax.nn.silu(xbc)
    xs, bm, cm = jnp.split(xbc, [B_WIDTH, B_WIDTH + B_GROUPS * B_STATE], axis=-1)
    xs = xs.reshape(b, L, B_HEADS, B_HEAD_DIM)
    dt = jax.nn.softplus(dtb.astype(f32) + lw['dt_bias'].astype(f32))
    a_neg = -jnp.exp(lw['a_log'].astype(f32))
    y, ssm_new = ssd_scan(xs, dt, a_neg, bm.reshape(b, L, B_GROUPS, B_STATE),
                          cm.reshape(b, L, B_GROUPS, B_STATE), ssm0)
    y = y + lw['d_skip'][:, None].astype(y.dtype) * xs
    y = y.reshape(b, L, B_WIDTH) * jax.nn.silu(zb)
    y = rmsnorm(y.reshape(b, L, B_GROUPS, B_WIDTH // B_GROUPS),
                lw['g_ssm_norm'].reshape(B_GROUPS, B_WIDTH // B_GROUPS)).reshape(b, L, B_WIDTH)
    yb = y @ lw['w_b_proj']
    xc, conv_c_new = causal_conv(xc, conv_c0, lw['conv_c_w'], lw['conv_c_b'])
    hc, lru_new = rg_lru(xc, lru0, lw['w_rgate'], lw['b_rgate'], lw['w_igate'], lw['b_igate'],
                         lw['lru_lambda'])
    yc = (hc * jax.nn.gelu(gc)) @ lw['w_c_proj']
    ga, gb, gcc = jnp.split(jax.nn.sigmoid(gates), 3, axis=-1)
    out = (ga * ya + gb * yb + gcc * yc) @ lw['w_out']
    return out, (new_kv[0], new_kv[1], new_kv[2], conv_b_new, ssm_new, conv_c_new, lru_new)


def block(x, c, lw, st, rel_bias, prompt):
    mod = jax.nn.silu(c) @ lw['w_ada'] + lw['b_ada']
    sh1, sc1, g1, sh2, sc2, g2, sh3, sc3, g3 = jnp.split(mod[:, None, :], N_MOD, axis=-1)
    h = rmsnorm(x, lw['g_ff1']) * (1 + sc1) + sh1
    x = x + 0.5 * g1 * swiglu(h, lw['w_ff1_in'], lw['w_ff1_out'])
    h = rmsnorm(x, lw['g_mix']) * (1 + sc2) + sh2
    m, new_st = mixer(h, lw, st, rel_bias, prompt)
    x = x + g2 * m
    h = rmsnorm(x, lw['g_ff2']) * (1 + sc3) + sh3
    x = x + 0.5 * g3 * swiglu(h, lw['w_ff2_in'], lw['w_ff2_out'])
    return x, new_st


def setup_inputs(seed: int = 0) -> dict:
    key = jax.random.key(seed)
    ks = iter(jax.random.split(key, 64))
    f32 = jnp.float32

    def nrm(shape, scale):
        return jax.random.normal(next(ks), shape, f32) * scale

    wb = [min(w, PAST_LEN) for w, _ in A_GROUPS]
    dt0 = jnp.exp(jax.random.uniform(next(ks), (DEPTH, B_HEADS), f32, math.log(1e-3), math.log(1e-1)))
    a_init = jax.random.uniform(next(ks), (DEPTH, B_HEADS), f32, 1.0, 16.0)
    a0 = jax.random.uniform(next(ks), (DEPTH, C_WIDTH), f32, 0.9, 0.999)
    sig = a0 ** (1.0 / C_POW)
    D = D_MODEL
    return {
        "x_prompt": nrm((BATCH, SEQ, D), 1.0),
        "x_sample": nrm((DEC_BATCH, DEC_SEQ, D), 1.0),
        "c_prompt": nrm((BATCH, D), 1.0),
        "c_sample": nrm((DEC_BATCH, D), 1.0),
        "cache_win1_kv": nrm((DEPTH, DEC_BATCH, wb[0], 2, A_HEADS, A_HEAD_DIM), 1.0),
        "cache_win2_kv": nrm((DEPTH, DEC_BATCH, wb[1], 2, A_HEADS, A_HEAD_DIM), 1.0),
        "cache_win3_kv": nrm((DEPTH, DEC_BATCH, wb[2], 2, A_HEADS, A_HEAD_DIM), 1.0),
        "state_conv_b": nrm((DEPTH, DEC_BATCH, B_CONV - 1, B_CONV_CH), 1.0),
        "state_ssm": nrm((DEPTH, DEC_BATCH, B_HEADS, B_HEAD_DIM, B_STATE), 0.1),
        "state_conv_c": nrm((DEPTH, DEC_BATCH, C_CONV - 1, C_WIDTH), 1.0),
        "state_lru": nrm((DEPTH, DEC_BATCH, C_WIDTH), 0.5),
        "rel_bias": nrm((REL_BUCKETS, A_N_GROUPS * A_HEADS), 0.2),
        "w_ada": nrm((DEPTH, D, N_MOD * D), 0.5 * D ** -0.5),
        "b_ada": nrm((DEPTH, N_MOD * D), 0.02),
        "g_ff1": 1.0 + nrm((DEPTH, D), 0.05),
        "w_ff1_in": nrm((DEPTH, D, 2 * D_FF), D ** -0.5),
        "w_ff1_out": nrm((DEPTH, D_FF, D), D_FF ** -0.5),
        "g_mix": 1.0 + nrm((DEPTH, D), 0.05),
        "w_in": nrm((DEPTH, D, N_IN), D ** -0.5),
        "w_a_proj": nrm((DEPTH, A_WIDTH, D), A_WIDTH ** -0.5),
        "conv_b_w": nrm((DEPTH, B_CONV, B_CONV_CH), B_CONV ** -0.5),
        "conv_b_b": nrm((DEPTH, B_CONV_CH), 0.02),
        "dt_bias": dt0 + jnp.log(-jnp.expm1(-dt0)),
        "a_log": jnp.log(a_init),
        "d_skip": 1.0 + nrm((DEPTH, B_HEADS), 0.05),
        "g_ssm_norm": 1.0 + nrm((DEPTH, B_WIDTH), 0.05),
        "w_b_proj": nrm((DEPTH, B_WIDTH, D), B_WIDTH ** -0.5),
        "conv_c_w": nrm((DEPTH, C_CONV, C_WIDTH), C_CONV ** -0.5),
        "conv_c_b": nrm((DEPTH, C_WIDTH), 0.02),
        "w_rgate": nrm((DEPTH, C_BLOCKS, C_BLOCK_DIM, C_BLOCK_DIM), C_BLOCK_DIM ** -0.5),
        "b_rgate": nrm((DEPTH, C_WIDTH), 0.02),
        "w_igate": nrm((DEPTH, C_BLOCKS, C_BLOCK_DIM, C_BLOCK_DIM), C_BLOCK_DIM ** -0.5),
        "b_igate": nrm((DEPTH, C_WIDTH), 0.02),
        "lru_lambda": jnp.log(sig) - jnp.log1p(-sig),
        "w_c_proj": nrm((DEPTH, C_WIDTH, D), C_WIDTH ** -0.5),
        "w_out": nrm((DEPTH, D, D), D ** -0.5),
        "g_ff2": 1.0 + nrm((DEPTH, D), 0.05),
        "w_ff2_in": nrm((DEPTH, D, 2 * D_FF), D ** -0.5),
        "w_ff2_out": nrm((DEPTH, D_FF, D), D_FF ** -0.5),
        "g_final": 1.0 + nrm((D,), 0.05),
    }


def reference(x_prompt, x_sample, c_prompt, c_sample, cache_win1_kv, cache_win2_kv, cache_win3_kv,
              state_conv_b, state_ssm, state_conv_c, state_lru, rel_bias, w_ada, b_ada, g_ff1,
              w_ff1_in, w_ff1_out, g_mix, w_in, w_a_proj, conv_b_w, conv_b_b, dt_bias, a_log, d_skip,
              g_ssm_norm, w_b_proj, conv_c_w, conv_c_b, w_rgate, b_rgate, w_igate, b_igate, lru_lambda,
              w_c_proj, w_out, g_ff2, w_ff2_in, w_ff2_out, g_final):
    yp, ys = x_prompt, x_sample
    new_p = [[] for _ in range(7)]
    new_s = [[] for _ in range(7)]
    for l in range(DEPTH):
        lw = dict(w_ada=w_ada[l], b_ada=b_ada[l], g_ff1=g_ff1[l], w_ff1_in=w_ff1_in[l],
                  w_ff1_out=w_ff1_out[l], g_mix=g_mix[l], w_in=w_in[l], w_a_proj=w_a_proj[l],
                  conv_b_w=conv_b_w[l], conv_b_b=conv_b_b[l], dt_bias=dt_bias[l], a_log=a_log[l],
                  d_skip=d_skip[l], g_ssm_norm=g_ssm_norm[l], w_b_proj=w_b_proj[l],
                  conv_c_w=conv_c_w[l], conv_c_b=conv_c_b[l], w_rgate=w_rgate[l], b_rgate=b_rgate[l],
                  w_igate=w_igate[l], b_igate=b_igate[l], lru_lambda=lru_lambda[l],
                  w_c_proj=w_c_proj[l], w_out=w_out[l], g_ff2=g_ff2[l], w_ff2_in=w_ff2_in[l],
                  w_ff2_out=w_ff2_out[l])
        st = dict(kv=(cache_win1_kv[l], cache_win2_kv[l], cache_win3_kv[l]), conv_b=state_conv_b[l],
                  ssm=state_ssm[l], conv_c=state_conv_c[l], lru=state_lru[l])
        yp, stp = block(yp, c_prompt, lw, None, rel_bias, True)
        ys, sts = block(ys, c_sample, lw, st, rel_bias, False)
        for i in range(7):
            new_p[i].append(stp[i])
            new_s[i].append(sts[i])
    yp = rmsnorm(yp, g_final)
    ys = rmsnorm(ys, g_final)
    p_kv1, p_kv2, p_kv3, p_conv_b, p_ssm, p_conv_c, p_lru = [jnp.stack(v, 0) for v in new_p]
    s_kv1, s_kv2, s_kv3, s_conv_b, s_ssm, s_conv_c, s_lru = [jnp.stack(v, 0) for v in new_s]
    return (yp, ys, p_kv1, p_kv2, p_kv3, p_conv_b, p_ssm, p_conv_c, p_lru,
            s_kv1, s_kv2, s_kv3, s_conv_b, s_ssm, s_conv_c, s_lru)
```

```cpp
#include <hip/hip_runtime.h>
#include <cstdio>
#include <cstdint>
#include <cmath>

#ifndef ONE_LAUNCH
#define ONE_LAUNCH 1
#endif

#define GAS __attribute__((address_space(1)))
#define LAS __attribute__((address_space(3)))
typedef unsigned short bf16;
typedef unsigned v4u __attribute__((ext_vector_type(4)));
typedef unsigned v2u __attribute__((ext_vector_type(2)));
typedef float f32x4 __attribute__((ext_vector_type(4)));
typedef short bf16x8 __attribute__((ext_vector_type(8)));
typedef short s16x4 __attribute__((ext_vector_type(4)));

constexpr int DM = 1024, NPROMPT = 16 * 2048, NSAMP = 256, M = NPROMPT + NSAMP, SEQ = 2048;
constexpr int DFF = 2816, NZ = 12288, NIN = 12304, NSEQ = 48, NMOD = 9216;
constexpr float EPS = 1e-6f;
constexpr int ZQ = 0, ZK = 1536, ZV = 3072, ZZB = 4608, ZXBC = 5632, ZXC = 7168, ZGC = 8192, ZGATE = 9216;

constexpr size_t MiB = 1u << 20;
constexpr size_t WS_CTL = 0, CTL_ZERO_BYTES = 1 * MiB;
constexpr size_t WS_WL = 1 * MiB, WL_STRIDE = 69 * MiB;
constexpr size_t WL_F1I = 0, WL_F1O = 11 * MiB, WL_IN = 17 * MiB  , WL_A = 67 * MiB  , WL_B = 43 * MiB, WL_C = 45 * MiB, WL_O = 47 * MiB,
                 WL_F2I = 49 * MiB, WL_F2O = 60 * MiB, WL_G = 66 * MiB;
constexpr int NZT = 12544;
constexpr size_t WS_WADA = WS_WL + 2 * WL_STRIDE;
constexpr size_t WS_SC = WS_WADA + 36 * MiB;
constexpr size_t WS_BIAS = WS_SC + 1 * MiB;
constexpr size_t WS_SPL = WS_BIAS + 512 * 1024;
constexpr size_t WS_MOD = WS_BIAS + 1 * MiB;
constexpr size_t WS_DT = WS_MOD + 4 * MiB;
constexpr size_t WS_LSE = WS_DT + 3 * MiB;
constexpr size_t WS_GAM = WS_LSE + 4 * MiB;
constexpr size_t WS_SHB = WS_GAM + 2 * MiB;
constexpr size_t WS_SHW1 = WS_SHB + 3 * MiB;
constexpr size_t WS_SHW2 = WS_SHW1 + 3 * MiB;
constexpr size_t WS_SHW3 = WS_SHW2 + 5 * MiB;
constexpr size_t WS_SSQ = WS_SHW3 + 3 * MiB;
constexpr size_t WS_X = WS_SSQ + 3 * MiB;
constexpr size_t WS_XB = WS_X + 129 * MiB;
constexpr size_t WS_MG = WS_XB + 65 * MiB;
constexpr size_t WS_Z = WS_MG + 65 * MiB;
constexpr size_t WS_XBCV = WS_Z + 774 * MiB;
constexpr size_t WS_XCV = WS_XBCV + 97 * MiB;
constexpr size_t WS_AL = WS_XCV + 65 * MiB;
constexpr size_t WS_U = WS_AL + 129 * MiB;
constexpr size_t WS_OG = WS_U + 129 * MiB;
constexpr size_t WS_YS = WS_OG + 97 * MiB;
constexpr size_t WS_OA = WS_YS + 129 * MiB;
constexpr size_t WS_HCG = WS_OA + 65 * MiB;
constexpr size_t WS_END = WS_HCG + 65 * MiB;

constexpr size_t O_YP = 0, O_YS = O_YP + 33554432, O_PKV1 = O_YS + 262144, O_PKV2 = O_PKV1 + 4194304, O_PKV3 = O_PKV2 + 16777216,
                 O_PCB = O_PKV3 + 67108864, O_PSSM = O_PCB + 147456, O_PCC = O_PSSM + 4194304, O_PLRU = O_PCC + 98304,
                 O_SKV1 = O_PLRU + 32768, O_SKV2 = O_SKV1 + 524288, O_SKV3 = O_SKV2 + 524288, O_SCB = O_SKV3 + 524288,
                 O_SSSM = O_SCB + 294912, O_SCC = O_SSSM + 8388608, O_SLRU = O_SCC + 196608, O_END = O_SLRU + 65536;

enum { I_XP = 0, I_XS, I_CP, I_CS, I_KV1, I_KV2, I_KV3, I_SCB, I_SSSM, I_SCC, I_SLRU, I_RELB, I_WADA, I_BADA, I_GFF1, I_WF1I, I_WF1O, I_GMIX, I_WIN,
       I_WA, I_CBW, I_CBB, I_DTB, I_ALOG, I_DSKIP, I_GSSM, I_WB, I_CCW, I_CCB, I_WR, I_BR, I_WI, I_BI, I_LAM, I_WC, I_WO, I_GFF2, I_WF2I, I_WF2O, I_GFIN, N_INPUTS };

__device__ __forceinline__ unsigned pk2(float lo, float hi) { unsigned r; asm("v_cvt_pk_bf16_f32 %0, %1, %2" : "=v"(r) : "v"(lo), "v"(hi)); return r; }
__device__ __forceinline__ unsigned f2bf(float f) { return pk2(f, 0.f) & 0xffffu; }
__device__ __forceinline__ float bflo(unsigned w) { return __builtin_bit_cast(float, w << 16); }
__device__ __forceinline__ float bfhi(unsigned w) { return __builtin_bit_cast(float, w & 0xffff0000u); }
__device__ __forceinline__ float bf2f(bf16 x) { return __builtin_bit_cast(float, (unsigned)x << 16); }
__device__ __forceinline__ void unpack8(const v4u w, float (&o)[8]) { o[0] = bflo(w.x); o[1] = bfhi(w.x); o[2] = bflo(w.y); o[3] = bfhi(w.y); o[4] = bflo(w.z); o[5] = bfhi(w.z); o[6] = bflo(w.w); o[7] = bfhi(w.w); }
__device__ __forceinline__ v4u pack8(const float (&o)[8]) { v4u w; w.x = pk2(o[0], o[1]); w.y = pk2(o[2], o[3]); w.z = pk2(o[4], o[5]); w.w = pk2(o[6], o[7]); return w; }
__device__ __forceinline__ float rcpf_(float x) { return __builtin_amdgcn_rcpf(x); }
__device__ __forceinline__ float sigmoidf_(float x) { return rcpf_(1.f + __expf(-x)); }
__device__ __forceinline__ float siluf_(float x) { return x * rcpf_(1.f + __expf(-x)); }
__device__ __forceinline__ float softplusf_(float x) { const float e = __expf(x); const float sm = e * (1.f - e * (0.5f - e * 0.33333334f)); return x > 20.f ? x : (e < 0.01f ? sm : __logf(1.f + e)); }
__device__ __forceinline__ float one_minus_exp(float y) { const float p = -y * (1.f + y * (0.5f + y * (0.16666667f + y * (0.041666668f + y * (0.0083333338f + y * 0.0013888889f))))); return y < -0.4f ? 1.f - __expf(y) : p; }
__device__ __forceinline__ float gelu_tanh(float x) { const float t = 0.7978845608028654f * (x + 0.044715f * x * x * x); return x * rcpf_(1.f + __expf(-2.f * t)); }
#define ZP(Zb, row, col) ((Zb) + ((size_t)((col) >> 8) * M + (size_t)(row)) * 256 + ((col) & 255))
__device__ __forceinline__ int seq_of_row(int row) { return row < NPROMPT ? (row >> 11) : 16 + ((row - NPROMPT) >> 3); }
__device__ __forceinline__ float wave_sum(float v) {
#pragma unroll
    for (int o = 1; o < 64; o <<= 1) v += __shfl_xor(v, o);
    return v;
}
__device__ __forceinline__ float wave_max(float v) {
#pragma unroll
    for (int o = 1; o < 64; o <<= 1) v = fmaxf(v, __shfl_xor(v, o));
    return v;
}
#define LDS_WAIT() asm volatile("s_waitcnt lgkmcnt(0)" ::: "memory")
#define LBAR() asm volatile("s_waitcnt lgkmcnt(0)\n\ts_barrier" ::: "memory")
__device__ __forceinline__ int lane_id() { return (int)__builtin_amdgcn_mbcnt_hi(~0u, __builtin_amdgcn_mbcnt_lo(~0u, 0u)); }
__device__ __forceinline__ v2u tr_read(const LAS bf16* tile, int stride, int r0, int c0, int qq) {
    typedef short v4i16_t __attribute__((ext_vector_type(4)));
    const LAS bf16* p = tile + (r0 + (qq >> 2)) * stride + c0 + 4 * (qq & 3);
    return __builtin_bit_cast(v2u, __builtin_amdgcn_ds_read_tr16_b64_v4i16((LAS v4i16_t*)p));
}

namespace pg8 {
#define PG8_LAS __attribute__((address_space(3)))
typedef unsigned short bf16_t;
typedef unsigned u32x4 __attribute__((ext_vector_type(4)));
constexpr int BM = 256, BK = 64, HALF = 128, HTB = HALF * BK * 2, STAGE_BYTES = 8 * HTB, NXCD = 8, WGM = 4;

__host__ __device__ __forceinline__ int lds_byte(int r, int c) { const int st = (r >> 4) * 2 + (c >> 5), rr = r & 15, cc = c & 31, ob = rr * 64 + cc * 2; return st * 1024 + (ob ^ (((ob >> 9) & 1) << 5)); }
__host__ __device__ __forceinline__ void stage_rc(int b, int& R, int& C) { const int st = b / 1024, sb = b % 1024, swz = sb ^ (((sb >> 9) & 1) << 5); R = (st >> 1) * 16 + swz / 64; C = (st & 1) * 32 + (swz % 64) / 2; }
__host__ __device__ __forceinline__ int perm32(int rho) { const int n = rho >> 4, i = rho & 15; return 8 * (i >> 2) + 4 * n + (i & 3); }

struct Unit { int pm, pn, half, seg; };
struct Gemm { const bf16_t* A; const bf16_t* Bt; int M, N, K, lda, ldb, a_pn_step; const bf16_t* A1; const bf16_t* Bt1; const bf16_t* A2; const bf16_t* Bt2; int K0; };

struct StaticOrder {
    int nM, nN, nwg, G, c;
    __host__ __device__ void init(int M_, int N_, int G_, int c_) { nM = M_ / BM; nN = N_ / BM; nwg = nM * nN; G = G_; c = c_; }
    __host__ __device__ bool next(int i, Unit& u) const {
        const long L = (long)i * G + c; if (L >= nwg) return false;
        int wgid = (int)L; { const int q = nwg / NXCD, r = nwg % NXCD, xcd = wgid % NXCD, off = wgid / NXCD; wgid = (xcd < r ? xcd * (q + 1) : r * (q + 1) + (xcd - r) * q) + off; }
        const int nig = WGM * nN, gid = wgid / nig, fm = gid * WGM, gsz = (nM - fm) < WGM ? (nM - fm) : WGM;
        u.pm = fm + ((wgid % nig) % gsz); u.pn = (wgid % nig) / gsz; u.half = -1; u.seg = 0; return true;
    }
};

__device__ __forceinline__ unsigned cvt_pk_bf16(float lo, float hi) { unsigned r; asm volatile("v_cvt_pk_bf16_f32 %0, %1, %2" : "=v"(r) : "v"(lo), "v"(hi)); return r; }

template <class Epi, class Sched, bool SEG3 = false>
__device__ __forceinline__ void gemm_phase(PG8_LAS unsigned char* lds, const Gemm g, const Sched& S, const Epi& E) {
    int tid_ = threadIdx.x; asm volatile("" : "+v"(tid_));
    const int tid = tid_, wid = __builtin_amdgcn_readfirstlane(tid >> 6), lane = tid & 63, wr = wid >> 2, wc = wid & 3, fr = lane & 15, fq = lane >> 4;
    int K_ = g.K; asm volatile("" : "+s"(K_)); const int K = K_, nt = K / BK;
    unsigned voffA[2], voffB[2];
#pragma unroll
    for (int i = 0; i < 2; ++i) { int R, C; stage_rc(tid * 16 + i * 8192, R, C); const int Rb = (R & ~31) + perm32(R & 31);
        voffA[i] = (unsigned)(R * g.lda + C) * 2u; voffB[i] = (unsigned)(Rb * g.ldb + C) * 2u; }
    const size_t kstep = (size_t)(BK * 2);
    const size_t hsA = (size_t)HALF * g.lda * 2, hsB = (size_t)HALF * g.ldb * 2;
    const size_t tsA = 2 * hsA, tsB = 2 * hsB;
    const unsigned ldsw = (unsigned)wid * 1024u;
    const int aoff = lds_byte(wr * 64 + fr, fq * 8), boff = lds_byte(wc * 32 + fr, fq * 8);
#define PG8_SA(b, h) (((b) * 2 + (h)) * HTB)
#define PG8_SB(b, h) ((4 + (b) * 2 + (h)) * HTB)
#define PG8_STAGE(bufoff, gbase, voff) do { _Pragma("unroll") for (int _i = 0; _i < 2; ++_i) \
        __builtin_amdgcn_global_load_lds((const unsigned*)((const char*)(gbase) + (voff)[_i]), (PG8_LAS unsigned*)(lds + (bufoff) + ldsw + _i * 8192), 16, 0, 0); } while (0)
#define PG8_LDA(dst, b, h) do { _Pragma("unroll") for (int m = 0; m < 4; ++m) _Pragma("unroll") for (int k = 0; k < 2; ++k) dst[m][k] = *(const PG8_LAS bf16x8*)(lds + PG8_SA(b, h) + aoff + m * 2048 + k * 1024); } while (0)
#define PG8_LDB(dst, b, h) do { _Pragma("unroll") for (int n = 0; n < 2; ++n) _Pragma("unroll") for (int k = 0; k < 2; ++k) dst[n][k] = *(const PG8_LAS bf16x8*)(lds + PG8_SB(b, h) + boff + n * 2048 + k * 1024); } while (0)
#define PG8_MMA(ai, bj, At, Bt) do { __builtin_amdgcn_s_setprio(1); _Pragma("unroll") for (int m = 0; m < 4; ++m) _Pragma("unroll") for (int n = 0; n < 2; ++n) _Pragma("unroll") for (int k = 0; k < 2; ++k) \
        acc[ai][bj][m][n] = __builtin_amdgcn_mfma_f32_16x16x32_bf16(Bt[n][k], At[m][k], acc[ai][bj][m][n], 0, 0, 0); __builtin_amdgcn_s_setprio(0); } while (0)
#define PG8_WAIT_V(n) asm volatile("s_waitcnt vmcnt(" #n ")" ::: "memory")
#define PG8_WAIT_L(n) do { asm volatile("s_waitcnt lgkmcnt(" #n ")" ::: "memory"); __builtin_amdgcn_s_waitcnt(0xC07F); } while (0)
#define PG8_BAR __builtin_amdgcn_s_barrier()
#define PG8_SCHED __builtin_amdgcn_sched_barrier(0)
    Unit cur, nxt; int ui = 0;
    if (!S.next(0, cur)) return;
    f32x4 acc[2][2][4][2];
    { float zr_ = 0.f; asm volatile("" : "+v"(zr_));
#pragma unroll
    for (int a = 0; a < 2; ++a)
#pragma unroll
        for (int b = 0; b < 2; ++b)
#pragma unroll
            for (int m = 0; m < 4; ++m)
#pragma unroll
                for (int n = 0; n < 2; ++n) acc[a][b][m][n] = (f32x4){zr_, zr_, zr_, zr_}; }
#define PG8_UA(u_) ((const char*)(SEG3 ? ((u_).seg == 0 ? g.A : ((u_).seg == 1 ? g.A1 : g.A2)) : g.A) + (size_t)(u_).pm * tsA + (size_t)(u_).pn * g.a_pn_step * 2)
#define PG8_UB(u_) ((const char*)(SEG3 ? ((u_).seg == 0 ? g.Bt : ((u_).seg == 1 ? g.Bt1 : g.Bt2)) : g.Bt) + (size_t)(u_).pn * tsB)
#define PG8_UNT(u_) ((SEG3 && (u_).seg == 0) ? g.K0 / BK : nt)
    const char* cA = PG8_UA(cur); const char* cB = PG8_UB(cur); int ntc = PG8_UNT(cur);
    PG8_STAGE(PG8_SB(0, 0), cB, voffB); PG8_STAGE(PG8_SB(0, 1), cB + hsB, voffB); PG8_STAGE(PG8_SA(0, 0), cA, voffA); PG8_STAGE(PG8_SA(0, 1), cA + hsA, voffA);
    if (wr == 1) PG8_BAR;
    PG8_WAIT_V(2); PG8_BAR;
    PG8_STAGE(PG8_SB(1, 0), cB + kstep, voffB); PG8_STAGE(PG8_SA(1, 0), cA + kstep, voffA); PG8_STAGE(PG8_SB(1, 1), cB + hsB + kstep, voffB);
    PG8_WAIT_V(6); PG8_BAR;
    for (;;) {
        const bool has_next = S.next(ui + 1, nxt);
        const char* nA = has_next ? PG8_UA(nxt) : cA; const char* nB = has_next ? PG8_UB(nxt) : cB; const int ntn = has_next ? PG8_UNT(nxt) : ntc;
        __builtin_amdgcn_s_waitcnt(0xC07F);
        for (int t = 0; t < ntc; t += 2) {
            bf16x8 At[4][2], B0[2][2], B1[2][2];
            const bool last = (t == ntc - 2);
            const char* a1 = cA + (size_t)(t + 1) * kstep;
            const char* a2 = last ? nA : cA + (size_t)(t + 2) * kstep; const char* b2 = last ? nB : cB + (size_t)(t + 2) * kstep;
            const char* a3 = a2 + kstep; const char* b3 = b2 + kstep;
            PG8_LDB(B0, 0, 0); PG8_LDB(B1, 0, 1); PG8_SCHED; PG8_LDA(At, 0, 0); PG8_STAGE(PG8_SA(1, 1), a1 + hsA, voffA);
            PG8_WAIT_V(8); PG8_WAIT_L(0); PG8_BAR; if (cur.half != 1) { PG8_MMA(0, 0, At, B0); PG8_MMA(0, 1, At, B1); } PG8_BAR; PG8_SCHED;
            PG8_LDA(At, 0, 1); PG8_STAGE(PG8_SB(0, 0), b2, voffB); PG8_STAGE(PG8_SB(0, 1), b2 + hsB, voffB); PG8_STAGE(PG8_SA(0, 0), a2, voffA);
            PG8_WAIT_V(8); PG8_WAIT_L(0); PG8_BAR; if (cur.half != 0) { PG8_MMA(1, 0, At, B0); PG8_MMA(1, 1, At, B1); } PG8_BAR; PG8_SCHED;
            PG8_LDB(B0, 1, 0); PG8_LDB(B1, 1, 1); PG8_SCHED; PG8_LDA(At, 1, 0); PG8_STAGE(PG8_SA(0, 1), a2 + hsA, voffA);
            PG8_WAIT_V(8); PG8_WAIT_L(0); PG8_BAR; if (cur.half != 1) { PG8_MMA(0, 0, At, B0); PG8_MMA(0, 1, At, B1); } PG8_BAR; PG8_SCHED;
            PG8_LDA(At, 1, 1); PG8_STAGE(PG8_SB(1, 0), b3, voffB); PG8_STAGE(PG8_SB(1, 1), b3 + hsB, voffB); PG8_STAGE(PG8_SA(1, 0), a3, voffA);
            PG8_WAIT_V(8); PG8_WAIT_L(0); PG8_BAR; if (cur.half != 0) { PG8_MMA(1, 0, At, B0); PG8_MMA(1, 1, At, B1); } PG8_BAR; PG8_SCHED;
        }
        if (wr == 0) PG8_BAR;
        E(acc, cur, wr, wc, fr, fq);
        if (!has_next) break;
        { float zr_ = 0.f; asm volatile("" : "+v"(zr_));
#pragma unroll
        for (int a = 0; a < 2; ++a)
#pragma unroll
            for (int b = 0; b < 2; ++b)
#pragma unroll
                for (int m = 0; m < 4; ++m)
#pragma unroll
                    for (int n = 0; n < 2; ++n) acc[a][b][m][n] = (f32x4){zr_, zr_, zr_, zr_}; }
        cur = nxt; cA = nA; cB = nB; ntc = ntn; ++ui;
        if (wr == 1) PG8_BAR;
    }
    PG8_WAIT_V(0);
    PG8_BAR;
#undef PG8_UA
#undef PG8_UB
#undef PG8_UNT
#undef PG8_SA
#undef PG8_SB
#undef PG8_STAGE
#undef PG8_LDA
#undef PG8_LDB
#undef PG8_MMA
#undef PG8_WAIT_V
#undef PG8_WAIT_L
#undef PG8_BAR
#undef PG8_SCHED
}

struct HalfOrder {
    StaticOrder mn; int nN, G, c;
    __host__ __device__ void init(int N_, int G_, int c_) { nN = N_ / BM; mn.init(NPROMPT, N_, G_, c_); G = G_; c = c_; }
    __host__ __device__ bool next(int i, Unit& u) const {
        const long L = (long)i * G + c;
        if (L < mn.nwg) return mn.next(i, u);
        const int j = (int)(L - mn.nwg); if (j >= 2 * nN) return false;
        u.pm = NPROMPT / BM; u.pn = j % nN; u.half = j / nN; u.seg = 0; return true;
    }
};
template <class Base> struct Seg3Order {
    Base b;
    __host__ __device__ bool next(int i, Unit& u) const { const int q = i / 3; if (!b.next(q, u)) return false; u.seg = i - 3 * q; return true; }
};
struct SampleOrder {
    int nN, G, c;
    __host__ __device__ void init(int nN_, int G_, int c_) { nN = nN_; G = G_; c = c_; }
    __host__ __device__ bool next(int i, Unit& u) const { const long L = (long)i * G + c; if (L >= nN) return false; u.pm = NPROMPT / BM; u.pn = (int)L; u.half = -1; u.seg = 0; return true; }
};
#define EPI_ROWS_BEGIN _Pragma("unroll") for (int ai = 0; ai < 2; ++ai) if (ai == 0 ? u.half != 1 : u.half != 0) _Pragma("unroll") for (int m = 0; m < 4; ++m) {     const int row = u.pm * BM + ai * HALF + wr * 64 + m * 16 + fr;
#define EPI_ROWS_END }
typedef const f32x4 (&AccT)[2][2][4][2];

__device__ __forceinline__ float row_rs(const float* SSQ, int row, int fq) {
    const f32x4 a = *(const f32x4*)(SSQ + (size_t)row * 16 + 4 * fq);
    float t = (a.x + a.y) + (a.z + a.w);
    t += __shfl_xor(t, 16); t += __shfl_xor(t, 32);
    return __builtin_amdgcn_rsqf(t * (1.f / DM) + EPS);
}
struct EpiMod {
    float* MOD; const float* bada; bf16_t* SHB;
    __device__ __forceinline__ void operator()(AccT acc, const Unit& u, int wr, int wc, int fr, int fq) const {
        const int col0 = u.pn * BM + wc * 32 + 8 * fq;
        EPI_ROWS_BEGIN
            if (row < NSEQ) {
#pragma unroll
                for (int bj = 0; bj < 2; ++bj) { const int c = col0 + bj * HALF; const int l = c / NMOD, j = c - l * NMOD, chunk = j >> 10, cj = j & 1023, k = chunk / 3, kind = chunk - 3 * k;
                    float* o = MOD + ((size_t)(l * NSEQ + row)) * NMOD + j; const float* b = bada + c;
                    const f32x4 v0 = acc[ai][bj][m][0] + *(const f32x4*)b, v1 = acc[ai][bj][m][1] + *(const f32x4*)(b + 4);
                    *(f32x4*)o = v0; *(f32x4*)(o + 4) = v1;
                    if (kind == 0) { u32x4 w; w.x = cvt_pk_bf16(v0[0], v0[1]); w.y = cvt_pk_bf16(v0[2], v0[3]); w.z = cvt_pk_bf16(v1[0], v1[1]); w.w = cvt_pk_bf16(v1[2], v1[3]);
                        *(u32x4*)(SHB + ((size_t)(l * 3 + k) * 256 + row) * DM + cj) = w; }
 }
            }
        EPI_ROWS_END
    }
};
struct EpiShw {
    float* O; int N;
    __device__ __forceinline__ void operator()(AccT acc, const Unit& u, int wr, int wc, int fr, int fq) const {
        const int col0 = u.pn * BM + wc * 32 + 8 * fq;
        EPI_ROWS_BEGIN
            if (row < NSEQ) {
#pragma unroll
                for (int bj = 0; bj < 2; ++bj) { float* o = O + (size_t)row * N + col0 + bj * HALF; *(f32x4*)o = acc[ai][bj][m][0]; *(f32x4*)(o + 4) = acc[ai][bj][m][1]; } }
        EPI_ROWS_END
    }
};
struct EpiSwiGLU {
    bf16_t* Gb; const float* SSQ; const float* SHW;
    __device__ __forceinline__ void operator()(AccT acc, const Unit& u, int wr, int wc, int fr, int fq) const {
        const int col0 = u.pn * HALF + wc * 32 + 8 * fq, tc0 = u.pn * BM + wc * 32 + 8 * fq;
        const bool uni = u.pm < NPROMPT / BM;
        f32x4 su[2] = {(f32x4){0.f, 0.f, 0.f, 0.f}, (f32x4){0.f, 0.f, 0.f, 0.f}}, sv[2] = {(f32x4){0.f, 0.f, 0.f, 0.f}, (f32x4){0.f, 0.f, 0.f, 0.f}};
        if (uni) { const float* sw = SHW + (size_t)(u.pm >> 3) * (2 * DFF) + tc0; su[0] = *(const f32x4*)sw; su[1] = *(const f32x4*)(sw + 4); sv[0] = *(const f32x4*)(sw + HALF); sv[1] = *(const f32x4*)(sw + HALF + 4); }
        float rs8[8];
#pragma unroll
        for (int r8 = 0; r8 < 8; ++r8) rs8[r8] = row_rs(SSQ, u.pm * BM + (r8 >> 2) * HALF + wr * 64 + (r8 & 3) * 16 + fr, fq);
        EPI_ROWS_BEGIN
            const float rs = rs8[ai * 4 + m];
            if (!uni) { const float* sw = SHW + (size_t)seq_of_row(row) * (2 * DFF) + tc0; su[0] = *(const f32x4*)sw; su[1] = *(const f32x4*)(sw + 4); sv[0] = *(const f32x4*)(sw + HALF); sv[1] = *(const f32x4*)(sw + HALF + 4); }
            float o[8];
#pragma unroll
            for (int n = 0; n < 2; ++n)
#pragma unroll
                for (int e = 0; e < 4; ++e) { const float uu = rs * acc[ai][0][m][n][e] + su[n][e], vv = rs * acc[ai][1][m][n][e] + sv[n][e]; o[4 * n + e] = siluf_(uu) * vv; }
            u32x4 w; w.x = cvt_pk_bf16(o[0], o[1]); w.y = cvt_pk_bf16(o[2], o[3]); w.z = cvt_pk_bf16(o[4], o[5]); w.w = cvt_pk_bf16(o[6], o[7]);
            *(u32x4*)(Gb + (size_t)row * DFF + col0) = w;
        EPI_ROWS_END
    }
};
template <bool NEXT> struct EpiResid {
    bf16_t* X; const float* gate; float scale;
    bf16_t* XB; float* SSQ; const float* gam;
    template <int AI> __device__ __forceinline__ void half_rows(AccT acc, int row0, int col0, int slot, int sq, int fq, const f32x4 (&gsc)[4]) const {
        v4u xw[4][2];
#pragma unroll
        for (int m = 0; m < 4; ++m)
#pragma unroll
            for (int bj = 0; bj < 2; ++bj) xw[m][bj] = *(const v4u*)(X + (size_t)(row0 + m * 16) * DM + col0 + bj * HALF);
#pragma unroll
        for (int m = 0; m < 4; ++m) { const int row = row0 + m * 16;
            float ss = 0.f;
#pragma unroll
            for (int bj = 0; bj < 2; ++bj) { const size_t off = (size_t)row * DM + col0 + bj * HALF;
                float xi[8]; unpack8(xw[m][bj], xi);
                const f32x4 x0 = (f32x4){xi[0], xi[1], xi[2], xi[3]} + gsc[bj * 2] * acc[AI][bj][m][0], x1 = (f32x4){xi[4], xi[5], xi[6], xi[7]} + gsc[bj * 2 + 1] * acc[AI][bj][m][1];
                { u32x4 xs_; xs_.x = cvt_pk_bf16(x0[0], x0[1]); xs_.y = cvt_pk_bf16(x0[2], x0[3]); xs_.z = cvt_pk_bf16(x1[0], x1[1]); xs_.w = cvt_pk_bf16(x1[2], x1[3]); *(u32x4*)(X + off) = xs_; }
                if (NEXT) { ss += ((x0.x * x0.x + x0.y * x0.y) + (x0.z * x0.z + x0.w * x0.w)) + ((x1.x * x1.x + x1.y * x1.y) + (x1.z * x1.z + x1.w * x1.w));
                    const float* gp_ = gam + (size_t)sq * DM + col0 + bj * HALF; const f32x4 y0 = x0 * *(const f32x4*)gp_, y1 = x1 * *(const f32x4*)(gp_ + 4);
                    u32x4 w; w.x = cvt_pk_bf16(y0[0], y0[1]); w.y = cvt_pk_bf16(y0[2], y0[3]); w.z = cvt_pk_bf16(y1[0], y1[1]); w.w = cvt_pk_bf16(y1[2], y1[3]);
                    *(u32x4*)(XB + off) = w; } }
            if (NEXT) { ss += __shfl_xor(ss, 16); ss += __shfl_xor(ss, 32); if (fq == 0) SSQ[(size_t)row * 16 + slot] = ss; } }
    }
    __device__ __forceinline__ void operator()(AccT acc, const Unit& u, int wr, int wc, int fr, int fq) const {
        const int upm = u.pm, upn = u.pn, uhalf = u.half;
        const int col0 = upn * BM + wc * 32 + 8 * fq, sq = upm >> 3, slot = upn * 4 + wc, rbase = upm * BM + wr * 64 + fr;
        f32x4 gsc[4];
#pragma unroll
        for (int q = 0; q < 4; ++q) gsc[q] = *(const f32x4*)(gate + (size_t)sq * NMOD + col0 + (q >> 1) * HALF + 4 * (q & 1)) * scale;
        if (uhalf != 1) half_rows<0>(acc, rbase, col0, slot, sq, fq, gsc);
        if (uhalf != 0) half_rows<1>(acc, rbase + HALF, col0, slot, sq, fq, gsc);
    }
};
struct EpiZ {
    bf16_t* Z; const float* SSQ; const float* SHW; float* out; float* DT; const float* dtb; int l;
    __device__ __forceinline__ void operator()(AccT acc, const Unit& u, int wr, int wc, int fr, int fq) const {
        const int col0 = u.pn * BM + wc * 32 + 8 * fq;
        const bool uni = u.pm < NPROMPT / BM;
        f32x4 sh[2][2] = {{(f32x4){0.f, 0.f, 0.f, 0.f}, (f32x4){0.f, 0.f, 0.f, 0.f}}, {(f32x4){0.f, 0.f, 0.f, 0.f}, (f32x4){0.f, 0.f, 0.f, 0.f}}};
        if (uni) { const float* sw = SHW + (size_t)(u.pm >> 3) * NZT + col0;
#pragma unroll
            for (int bj = 0; bj < 2; ++bj) { sh[bj][0] = *(const f32x4*)(sw + bj * HALF); sh[bj][1] = *(const f32x4*)(sw + bj * HALF + 4); } }
        float rs8[8];
#pragma unroll
        for (int r8 = 0; r8 < 8; ++r8) rs8[r8] = row_rs(SSQ, u.pm * BM + (r8 >> 2) * HALF + wr * 64 + (r8 & 3) * 16 + fr, fq);
        const int side = (u.pn >= 6 && u.pn < 18) ? 1 : ((u.pn >= 22 && u.pn < 32) ? 2 : 0);
        EPI_ROWS_BEGIN
            const float rs = rs8[ai * 4 + m];
            const int sq = seq_of_row(row); const bool isS = row >= NPROMPT; const int t = isS ? ((row - NPROMPT) & 7) : (row & (SEQ - 1));
            if (!uni) { const float* sw = SHW + (size_t)sq * NZT + col0;
#pragma unroll
                for (int bj = 0; bj < 2; ++bj) { sh[bj][0] = *(const f32x4*)(sw + bj * HALF); sh[bj][1] = *(const f32x4*)(sw + bj * HALF + 4); }
                asm volatile("" :: "v"(sh[0][0]), "v"(sh[0][1]), "v"(sh[1][0]), "v"(sh[1][1])); }
#pragma unroll
            for (int bj = 0; bj < 2; ++bj) { const int c = col0 + bj * HALF;
                const f32x4 v0 = acc[ai][bj][m][0] * rs + sh[bj][0], v1 = acc[ai][bj][m][1] * rs + sh[bj][1];
                if (u.pn < 48) {
                    u32x4 w; w.x = cvt_pk_bf16(v0[0], v0[1]); w.y = cvt_pk_bf16(v0[2], v0[3]); w.z = cvt_pk_bf16(v1[0], v1[1]); w.w = cvt_pk_bf16(v1[2], v1[3]);
                    *(u32x4*)ZP(Z, row, c) = w;
                    if (side) {
                        float* dst = nullptr;
                        if (side == 1) {
                            const int kv = c >= ZV ? 1 : 0, cc = c - (kv ? ZV : ZK), g = cc >> 9, ci = cc & 511; const int keep = g == 0 ? 128 : (g == 1 ? 512 : 2048);
                            if (isS) dst = out + (g == 0 ? O_SKV1 : (g == 1 ? O_SKV2 : O_SKV3)) + ((size_t)(l * 32 + (sq - 16)) * 8 + t) * 1024 + kv * 512 + ci;
                            else if (t >= SEQ - keep) dst = out + (g == 0 ? O_PKV1 : (g == 1 ? O_PKV2 : O_PKV3)) + ((size_t)(l * 16 + sq) * keep + (t - (SEQ - keep))) * 1024 + kv * 512 + ci;
                        } else {
                            const int tl = isS ? 8 : SEQ;
                            if (t >= tl - 3) { const int i3 = t - (tl - 3);
                                if (c < ZXC) dst = out + (isS ? O_SCB + ((size_t)(l * 32 + (sq - 16)) * 3 + i3) * 1536 : O_PCB + ((size_t)(l * 16 + sq) * 3 + i3) * 1536) + (c - ZXBC);
                                else dst = out + (isS ? O_SCC + ((size_t)(l * 32 + (sq - 16)) * 3 + i3) * 1024 : O_PCC + ((size_t)(l * 16 + sq) * 3 + i3) * 1024) + (c - ZXC); }
                        }
                        if (dst) { *(f32x4*)dst = v0; *(f32x4*)(dst + 4) = v1; }
                    }
                } else if (bj == 0 && wc == 0 && fq < 2) {
                    float* d = DT + (size_t)row * 16 + 8 * fq; const float* bb = dtb + 8 * fq;
                    *(f32x4*)d = (f32x4){softplusf_(v0[0] + bb[0]), softplusf_(v0[1] + bb[1]), softplusf_(v0[2] + bb[2]), softplusf_(v0[3] + bb[3])};
                    *(f32x4*)(d + 4) = (f32x4){softplusf_(v1[0] + bb[4]), softplusf_(v1[1] + bb[5]), softplusf_(v1[2] + bb[6]), softplusf_(v1[3] + bb[7])};
                }
            }
        EPI_ROWS_END
    }
};
struct EpiLru {
    const bf16_t* XCV; const float* br; const float* bi; const float* lam; float* AL; float* U;
    __device__ __forceinline__ void operator()(AccT acc, const Unit& u, int wr, int wc, int fr, int fq) const {
        const int ch0 = u.pn * HALF + wc * 32 + 8 * fq;
        EPI_ROWS_BEGIN
#pragma unroll
            for (int n = 0; n < 2; ++n) { const int ch = ch0 + 4 * n;
                const f32x4 brv = *(const f32x4*)(br + ch), biv = *(const f32x4*)(bi + ch), sp = *(const f32x4*)(lam + ch);
                const v2u xw = *(const v2u*)(XCV + (size_t)row * DM + ch); const float xv[4] = {bflo(xw.x), bfhi(xw.x), bflo(xw.y), bfhi(xw.y)};
                f32x4 av, uv;
#pragma unroll
                for (int e = 0; e < 4; ++e) {
                    const float rg = sigmoidf_(acc[ai][0][m][n][e] + brv[e]), ig = sigmoidf_(acc[ai][1][m][n][e] + biv[e]);
                    const float la = sp[e] * rg; av[e] = __expf(la); uv[e] = xv[e] * ig * __builtin_amdgcn_sqrtf(one_minus_exp(2.f * la)); }
                *(f32x4*)(AL + (size_t)row * DM + ch) = av; *(f32x4*)(U + (size_t)row * DM + ch) = uv; }
        EPI_ROWS_END
    }
};
struct EpiMerge3 {
    const bf16_t* Zg;
    bf16_t* ACC; bf16_t* MG;
    template <int AI> __device__ __forceinline__ void half_rows(AccT acc, int row0, int col0, int seg) const {
        v4u gw[4][2], pw[4][2];
#pragma unroll
        for (int m = 0; m < 4; ++m)
#pragma unroll
            for (int bj = 0; bj < 2; ++bj) { gw[m][bj] = *(const v4u*)ZP(Zg, row0 + m * 16, ZGATE + seg * DM + col0 + bj * HALF);
                pw[m][bj] = (v4u){0u, 0u, 0u, 0u}; if (seg > 0) pw[m][bj] = *(const v4u*)(ACC + (size_t)(row0 + m * 16) * DM + col0 + bj * HALF); }
#pragma unroll
        for (int m = 0; m < 4; ++m)
#pragma unroll
            for (int bj = 0; bj < 2; ++bj) { const size_t off = (size_t)(row0 + m * 16) * DM + col0 + bj * HALF;
                float gv[8], pv[8], o[8]; unpack8(gw[m][bj], gv); unpack8(pw[m][bj], pv);
#pragma unroll
                for (int n = 0; n < 2; ++n)
#pragma unroll
                    for (int e = 0; e < 4; ++e) o[4 * n + e] = pv[4 * n + e] + sigmoidf_(gv[4 * n + e]) * acc[AI][bj][m][n][e];
                u32x4 w; w.x = cvt_pk_bf16(o[0], o[1]); w.y = cvt_pk_bf16(o[2], o[3]); w.z = cvt_pk_bf16(o[4], o[5]); w.w = cvt_pk_bf16(o[6], o[7]);
                if (seg < 2) *(u32x4*)(ACC + off) = w; else *(u32x4*)(MG + off) = w; }
    }
    __device__ __forceinline__ void operator()(AccT acc, const Unit& u, int wr, int wc, int fr, int fq) const {
        const int upm = u.pm, upn = u.pn, uhalf = u.half, seg = u.seg;
        const int col0 = upn * BM + wc * 32 + 8 * fq, rbase = upm * BM + wr * 64 + fr;
        if (uhalf != 1) half_rows<0>(acc, rbase, col0, seg);
        if (uhalf != 0) half_rows<1>(acc, rbase + HALF, col0, seg);
    }
};
}

#define XB_TMO      128
#define XB_XCNT(j)  (256  + 64 * (j))
#define XB_XSUB(j)  (1280 + 64 * (j))
#define XB_XGEN(j)  (2304 + 64 * (j))
#define XB_TOP      3328
#define XB_TOPGEN   3392
#define XCD_BAR_WORDS 3456
#define XB_SPIN_CAP (1u << 18)
__device__ __forceinline__ unsigned xb_ld(unsigned* p)              { return __hip_atomic_load(p, __ATOMIC_RELAXED, __HIP_MEMORY_SCOPE_AGENT); }
__device__ __forceinline__ unsigned xb_add(unsigned* p, unsigned v) { return __hip_atomic_fetch_add(p, v, __ATOMIC_RELAXED, __HIP_MEMORY_SCOPE_AGENT); }
__device__ __forceinline__ unsigned xb_xcc_id() { return (unsigned)__builtin_amdgcn_s_getreg((3 << 11) | 20) & 0xFu; }
#define XB_SPIN(cond, bar) do { unsigned _sp = 0; while (cond) { __builtin_amdgcn_s_sleep(1); \
    if ((++_sp & 255u) == 0u) { if (xb_ld(&(bar)[XB_TMO])) break; if (_sp > XB_SPIN_CAP) { atomicAdd(&(bar)[XB_TMO], 1u); break; } } } } while (0)
struct XcdBarrier { unsigned* bar; unsigned x; volatile LAS unsigned* st; };
__device__ __forceinline__ XcdBarrier xcd_barrier_post(unsigned* bar, volatile LAS unsigned* st, int tid) {
    XcdBarrier b; b.bar = bar; b.x = xb_xcc_id(); b.st = st;
    if (tid == 0) (void)xb_add(&bar[XB_XCNT(b.x)], 1u);
    return b;
}
__device__ __forceinline__ void xcd_barrier_complete(unsigned* bar, unsigned x, unsigned& nloc, unsigned& nx) {
    const unsigned G = gridDim.x * gridDim.y * gridDim.z;
    unsigned sum, cnt, mine, sp = 0u;
    for (;;) {
        sum = 0u; cnt = 0u; mine = 0u;
#pragma unroll
        for (unsigned j = 0; j < 16; ++j) { const unsigned c = xb_ld(&bar[XB_XCNT(j)]); sum += c; cnt += (c > 0u) ? 1u : 0u; mine = (j == x) ? c : mine; }
        if (sum == G) break;
        __builtin_amdgcn_s_sleep(1);
        if ((++sp & 255u) == 0u) { if (xb_ld(&bar[XB_TMO])) break; if (sp > XB_SPIN_CAP) { atomicAdd(&bar[XB_TMO], 1u); break; } }
    }
    nloc = mine > 0u ? mine : 1u; nx = cnt > 0u ? cnt : 1u;
}
__device__ __forceinline__ void xcd_barrier(const XcdBarrier& b, int tid) {
    asm volatile("s_waitcnt vmcnt(0)" ::: "memory");
    __syncthreads();
    if (tid == 0) {
        unsigned* bar = b.bar;
        __builtin_amdgcn_s_waitcnt(0);
        unsigned nloc = b.st[0], nx = b.st[1];
        if (nloc == 0u) { xcd_barrier_complete(bar, b.x, nloc, nx); b.st[0] = nloc; b.st[1] = nx; }
        const unsigned old = xb_add(&bar[XB_XSUB(b.x)], 1u);
        const unsigned gen = old / nloc;
        if (old + 1u == (gen + 1u) * nloc) {
            __builtin_amdgcn_fence(__ATOMIC_RELEASE, "agent");
            asm volatile("s_waitcnt vmcnt(0)" ::: "memory");
            const unsigned og = xb_add(&bar[XB_TOP], 1u);
            const unsigned tg = og / nx;
            if (og + 1u == (tg + 1u) * nx) xb_add(&bar[XB_TOPGEN], 1u);
            else XB_SPIN(xb_ld(&bar[XB_TOPGEN]) == tg, bar);
            __builtin_amdgcn_fence(__ATOMIC_ACQUIRE, "agent");
            xb_add(&bar[XB_XGEN(b.x)], 1u);
            asm volatile("s_waitcnt vmcnt(0)" ::: "memory");
        } else {
            XB_SPIN(xb_ld(&bar[XB_XGEN(b.x)]) == gen, bar);
            __builtin_amdgcn_fence(__ATOMIC_ACQUIRE, "agent");
            asm volatile("s_waitcnt vmcnt(0)" ::: "memory");
        }
    }
    __syncthreads();
}

constexpr int NWAVES = 8;
constexpr int LDS_BYTES = 147456, LDSCTL_OFF = LDS_BYTES - 512, MISC_OFF = LDSCTL_OFF + 320;
constexpr int CW_BAR = 4096;
constexpr int NPH_LAYER = 10, PH_L0 = 3, PH_FINAL = PH_L0 + 2 * NPH_LAYER, NPHASES = PH_FINAL + 1;

struct Args { const float* in[N_INPUTS]; float* out; unsigned char* ws; int ph_lo, ph_hi, use_bar, li; unsigned submask; int pad; };
typedef const __attribute__((address_space(4))) Args* KArgs;
__device__ __forceinline__ KArgs kargs() { KArgs p = (KArgs)__builtin_amdgcn_kernarg_segment_ptr(); asm volatile("" : "+s"(p)); return p; }
#define PH_PTRS KArgs A = kargs(); unsigned char* ws = A->ws; float* out = A->out; (void)out; \
    LAS unsigned char* lds = lds0; asm volatile("" : "+s"(lds));   \
    int G = G0, bx = bx0, vcu = vcu0; asm volatile("" : "+s"(G), "+s"(bx), "+s"(vcu)); const int NGW = G * NWAVES; (void)NGW;   \
    int tid = threadIdx.x; asm volatile("" : "+v"(tid)); const int lane = tid & 63, wave = __builtin_amdgcn_readfirstlane(tid >> 6), gw = vcu * NWAVES + wave; (void)lane; (void)wave; (void)gw; \
    bf16* SC = (bf16*)(ws + WS_SC); float* BIASG = (float*)(ws + WS_BIAS); float* MOD = (float*)(ws + WS_MOD); float* DT = (float*)(ws + WS_DT); \
    float* LSE = (float*)(ws + WS_LSE); bf16* X = (bf16*)(ws + WS_X);     bf16* XB = (bf16*)(ws + WS_XB); bf16* MG = (bf16*)(ws + WS_MG); float* SSQ = (float*)(ws + WS_SSQ); float* GAM = (float*)(ws + WS_GAM); bf16* SHB = (bf16*)(ws + WS_SHB); bf16* Z = (bf16*)(ws + WS_Z); bf16* Gb = Z; \
    bf16* XBCV = (bf16*)(ws + WS_XBCV); bf16* XCV = (bf16*)(ws + WS_XCV); bf16* YN = (bf16*)(ws + WS_U); bf16* ACC = (bf16*)(ws + WS_AL);     float* AL = (float*)(ws + WS_U + 66 * MiB); float* U = (float*)(ws + WS_U + 68 * MiB);     \
    bf16* OG = (bf16*)(ws + WS_OG); bf16* YS = (bf16*)(ws + WS_YS);     bf16* OA = (bf16*)(ws + WS_OA); bf16* HCG = (bf16*)(ws + WS_HCG); bf16* WADA = (bf16*)(ws + WS_WADA); \
    (void)SC; (void)BIASG; (void)MOD; (void)DT; (void)LSE; (void)X; (void)XB; (void)MG; (void)SSQ; (void)GAM; (void)SHB; (void)Z; (void)Gb; (void)XBCV; (void)XCV; (void)YN; (void)AL; (void)ACC; (void)U; (void)OG; (void)YS; (void)OA; (void)HCG; (void)WADA;
#define PH_LAYER unsigned char* wl = ws + WS_WL + (size_t)l * WL_STRIDE; const float* modl = MOD + (size_t)l * NSEQ * NMOD; \
    (void)wl; (void)modl;

__device__ __forceinline__ void cvt_item(const float* W, int ld, int K, bf16* WT, int dst_row0, LAS float* scr, int k0, int n0, int lane) {
#pragma unroll 8
    for (int i = 0; i < 32; ++i) { const int kk = 2 * i + (lane >> 5); scr[kk * 33 + (lane & 31)] = W[(size_t)(k0 + kk) * ld + n0 + (lane & 31)]; }
    LDS_WAIT(); asm volatile("" ::: "memory");
    const int c = lane & 7;
#pragma unroll
    for (int j = 0; j < 4; ++j) { const int n = (lane >> 3) + 8 * j; const LAS float* s = scr + (8 * c) * 33 + n;
        v4u o; o.x = pk2(s[0 * 33], s[1 * 33]); o.y = pk2(s[2 * 33], s[3 * 33]); o.z = pk2(s[4 * 33], s[5 * 33]); o.w = pk2(s[6 * 33], s[7 * 33]);
        *(v4u*)(WT + (size_t)(dst_row0 + n) * K + k0 + 8 * c) = o; }
    LDS_WAIT(); asm volatile("" ::: "memory");
}
__device__ __forceinline__ void cvt_mat(const float* W, int ld, int K, int ncols, bf16* WT, int mode, int row_off, LAS float* scr, int gw, int NGW, int& rot, int lane, int ldd = 0) {
    const int nblk = ncols / 32, nitems = (K / 64) * nblk; if (ldd == 0) ldd = K;
    int start = gw - (rot % NGW); if (start < 0) start += NGW;
    for (int it = start; it < nitems; it += NGW) {
        const int kb = it / nblk, nb = it - kb * nblk, n0 = 32 * nb;
        int dr;
        if (mode == 0) dr = row_off + n0;
        else { const int isv = n0 >= DFF, j = isv ? n0 - DFF : n0; dr = (j >> 7) * 256 + (isv ? 128 : 0) + (j & 127); }
        cvt_item(W, ld, ldd, WT, dr, scr, 64 * kb, n0, lane);
    }
    rot += nitems;
}

template <int K> __device__ __forceinline__ void sample_resid_units(LAS unsigned char* lds, const bf16* Aop, int lda, const bf16* Bt, int ldb, bf16* X, const float* gate, float scale,
                                                   bf16* XB, float* SSQ, const float* gam, int tid, int vcu, int G) {
    LAS float* P = (LAS float*)lds;
    LAS float* R = P + 8 * 1024;
    const int lane = tid & 63, w = __builtin_amdgcn_readfirstlane(tid >> 6), qq = lane & 15, q4 = lane >> 4;
    for (int un = vcu; un < 256; un += G) {
        const int rt = un >> 4, cs = un & 15, pn = cs >> 2, wc = cs & 3; const size_t row0 = (size_t)NPROMPT + 16 * rt;
        constexpr int kper = K >> 3; const int kbeg = w * kper;
        f32x4 acc[4];
#pragma unroll
        for (int ct = 0; ct < 4; ++ct) acc[ct] = (f32x4){0.f, 0.f, 0.f, 0.f};
        const bf16* ap = Aop + (row0 + qq) * (size_t)lda + kbeg + 8 * q4;
        const bf16* bp = Bt + (size_t)(256 * pn + 32 * wc + qq) * ldb + kbeg + 8 * q4;
#pragma unroll 4
        for (int k0 = 0; k0 < kper; k0 += 32) {
            const bf16x8 af = *(const bf16x8*)(ap + k0);
#pragma unroll
            for (int ct = 0; ct < 4; ++ct) { const bf16x8 bf = *(const bf16x8*)(bp + (size_t)(128 * (ct >> 1) + 16 * (ct & 1)) * ldb + k0);
                acc[ct] = __builtin_amdgcn_mfma_f32_16x16x32_bf16(bf, af, acc[ct], 0, 0, 0); } }
        __syncthreads();
#pragma unroll
        for (int ct = 0; ct < 4; ++ct)
#pragma unroll
            for (int i = 0; i < 4; ++i) P[((w * 4 + ct) * 4 + i) * 64 + lane] = acc[ct][i];
        __syncthreads();
        const int r = tid & 15, ct = tid >> 7, np = (tid >> 4) & 7, i0 = 2 * (np & 1), ln = r + 16 * (np >> 1);
        float s0 = 0.f, s1 = 0.f;
#pragma unroll
        for (int ww = 0; ww < 8; ++ww) { s0 += P[((ww * 4 + ct) * 4 + i0) * 64 + ln]; s1 += P[((ww * 4 + ct) * 4 + i0 + 1) * 64 + ln]; }
        const size_t row = row0 + r; const int sq = 16 + (int)((row - NPROMPT) >> 3);
        const int col = 256 * pn + 128 * (ct >> 1) + 32 * wc + 16 * (ct & 1) + 2 * np;
        const unsigned xw = *(const unsigned*)(X + row * DM + col);
        const float g0 = gate[(size_t)sq * NMOD + col], g1 = gate[(size_t)sq * NMOD + col + 1];
        const float x0 = bflo(xw) + scale * g0 * s0, x1 = bfhi(xw) + scale * g1 * s1;
        *(unsigned*)(X + row * DM + col) = pk2(x0, x1);
        const float m0 = gam[(size_t)sq * DM + col], m1 = gam[(size_t)sq * DM + col + 1];
        *(unsigned*)(XB + row * DM + col) = pk2(x0 * m0, x1 * m1);
        float ss = x0 * x0 + x1 * x1;
        ss += __shfl_xor(ss, 16); ss += __shfl_xor(ss, 32);
        if (lane < 16) R[r * 8 + w] = ss;
        __syncthreads();
        if (tid < 16) { float t = 0.f;
#pragma unroll
            for (int ww = 0; ww < 8; ++ww) t += R[tid * 8 + ww];
            SSQ[(row0 + tid) * 16 + cs] = t; }
    }
    __syncthreads();
}

__device__ __forceinline__ void sample_merge_units(LAS unsigned char* lds, const bf16* OA, const bf16* YN, const bf16* HCG, const bf16* Wa, const bf16* Wb, const bf16* Wc,
                                                   const bf16* Zg, bf16* MG, int tid, int vcu, int G) {
    LAS float* P = (LAS float*)lds;
    const int lane = tid & 63, w = __builtin_amdgcn_readfirstlane(tid >> 6), qq = lane & 15, q4 = lane >> 4;
    for (int un = vcu; un < 256; un += G) {
        const int rt = un >> 4, cs = un & 15, pn = cs >> 2, wc = cs & 3; const size_t row0 = (size_t)NPROMPT + 16 * rt;
        __syncthreads();
#pragma unroll
        for (int pr = 0; pr < 3; ++pr) {
            const bf16* Aop = pr == 0 ? OA : (pr == 1 ? YN : HCG); const bf16* Bt = pr == 0 ? Wa : (pr == 1 ? Wb : Wc); const int K = pr == 0 ? 512 : DM;
            const int kper = K >> 3, kbeg = w * kper;
            f32x4 acc[4];
#pragma unroll
            for (int ct = 0; ct < 4; ++ct) acc[ct] = (f32x4){0.f, 0.f, 0.f, 0.f};
            const bf16* ap = Aop + (row0 + qq) * (size_t)DM + kbeg + 8 * q4;
            const bf16* bp = Bt + (size_t)(256 * pn + 32 * wc + qq) * DM + kbeg + 8 * q4;
#pragma unroll
            for (int k0 = 0; k0 < kper; k0 += 32) {
                const bf16x8 af = *(const bf16x8*)(ap + k0);
#pragma unroll
                for (int ct = 0; ct < 4; ++ct) { const bf16x8 bf = *(const bf16x8*)(bp + (size_t)(128 * (ct >> 1) + 16 * (ct & 1)) * DM + k0);
                    acc[ct] = __builtin_amdgcn_mfma_f32_16x16x32_bf16(bf, af, acc[ct], 0, 0, 0); } }
#pragma unroll
            for (int ct = 0; ct < 4; ++ct)
#pragma unroll
                for (int i = 0; i < 4; ++i) P[pr * 8192 + ((w * 4 + ct) * 4 + i) * 64 + lane] = acc[ct][i];
        }
        __syncthreads();
        const int r = tid & 15, ct = tid >> 7, np = (tid >> 4) & 7, i0 = 2 * (np & 1), ln = r + 16 * (np >> 1);
        const size_t row = row0 + r; const int col = 256 * pn + 128 * (ct >> 1) + 32 * wc + 16 * (ct & 1) + 2 * np;
        float o0 = 0.f, o1 = 0.f;
#pragma unroll
        for (int pr = 0; pr < 3; ++pr) { float s0 = 0.f, s1 = 0.f;
#pragma unroll
            for (int ww = 0; ww < 8; ++ww) { s0 += P[pr * 8192 + ((ww * 4 + ct) * 4 + i0) * 64 + ln]; s1 += P[pr * 8192 + ((ww * 4 + ct) * 4 + i0 + 1) * 64 + ln]; }
            const unsigned gw = *(const unsigned*)ZP(Zg, row, ZGATE + pr * DM + col);
            o0 += sigmoidf_(bflo(gw)) * s0; o1 += sigmoidf_(bfhi(gw)) * s1; }
        *(unsigned*)(MG + row * DM + col) = pk2(o0, o1);
    }
    __syncthreads();
}

__device__ __forceinline__ void mod_small_units(LAS unsigned char* lds, const bf16* SC, const bf16* WADA, const float* bada, float* MOD, bf16* SHB, int tid, int vcu, int G) {
    LAS float* P = (LAS float*)lds;
    const int lane = tid & 63, w = __builtin_amdgcn_readfirstlane(tid >> 6), qq = lane & 15, q4 = lane >> 4;
    for (int un = vcu; un < 3 * 288; un += G) {
        const int rt = un / 288, cs = un - rt * 288;
        const int kbeg = w * 128;
        f32x4 acc[4];
#pragma unroll
        for (int ct = 0; ct < 4; ++ct) acc[ct] = (f32x4){0.f, 0.f, 0.f, 0.f};
        const bf16* ap = SC + (size_t)(16 * rt + qq) * DM + kbeg + 8 * q4;
        const bf16* bp = WADA + (size_t)(64 * cs + qq) * DM + kbeg + 8 * q4;
#pragma unroll
        for (int k0 = 0; k0 < 128; k0 += 32) {
            const bf16x8 af = *(const bf16x8*)(ap + k0);
#pragma unroll
            for (int ct = 0; ct < 4; ++ct) acc[ct] = __builtin_amdgcn_mfma_f32_16x16x32_bf16(*(const bf16x8*)(bp + (size_t)(16 * ct) * DM + k0), af, acc[ct], 0, 0, 0); }
        __syncthreads();
#pragma unroll
        for (int ct = 0; ct < 4; ++ct)
#pragma unroll
            for (int i = 0; i < 4; ++i) P[((w * 4 + ct) * 4 + i) * 64 + lane] = acc[ct][i];
        __syncthreads();
        const int r = tid & 15, ct = tid >> 7, np = (tid >> 4) & 7, i0 = 2 * (np & 1), ln = r + 16 * (np >> 1);
        float s0 = 0.f, s1 = 0.f;
#pragma unroll
        for (int ww = 0; ww < 8; ++ww) { s0 += P[((ww * 4 + ct) * 4 + i0) * 64 + ln]; s1 += P[((ww * 4 + ct) * 4 + i0 + 1) * 64 + ln]; }
        const int row = 16 * rt + r, c = 64 * cs + 16 * ct + 2 * np;
        const int l = c / NMOD, j = c - l * NMOD, chunk = j >> 10, cj = j & 1023, k = chunk / 3, kind = chunk - 3 * k;
        const float v0 = s0 + bada[c], v1 = s1 + bada[c + 1];
        float* o = MOD + ((size_t)(l * NSEQ + row)) * NMOD + j; o[0] = v0; o[1] = v1;
        if (kind == 0) *(unsigned*)(SHB + ((size_t)(l * 3 + k) * 256 + row) * DM + cj) = pk2(v0, v1);
    }
    __syncthreads();
}

__global__ void __launch_bounds__(NWAVES * 64, 2) fwd(Args args_unused) {
    extern __shared__ __attribute__((aligned(16))) unsigned char lds_raw[];
    LAS unsigned char* const lds0 = (LAS unsigned char*)lds_raw;
    volatile LAS unsigned* MISC = (volatile LAS unsigned*)(lds0 + MISC_OFF);
    const int tid0 = threadIdx.x;
    const int G0 = gridDim.x, bx0 = blockIdx.x;
    const int vcu0 = (G0 % 8 == 0) ? (bx0 % 8) * (G0 / 8) + bx0 / 8 : bx0;
    int lo, hi;
    { KArgs A0 = kargs(); lo = A0->ph_lo; hi = A0->ph_hi; }
    for (int u = tid0; u < (LDS_BYTES - LDSCTL_OFF) / 4; u += NWAVES * 64) ((LAS unsigned*)(lds0 + LDSCTL_OFF))[u] = 0u;
    __syncthreads();
    { KArgs A0 = kargs(); if (A0->use_bar) (void)xcd_barrier_post((unsigned*)(A0->ws + WS_CTL) + CW_BAR + A0->li * XCD_BAR_WORDS, MISC + 8, (int)threadIdx.x); }
#define IN(k) (lo <= (k) && (k) < hi)
#define SEAM(k) do { if (IN(k) && IN((k) + 1)) { KArgs Ab = kargs(); XcdBarrier bar_; bar_.bar = (unsigned*)(Ab->ws + WS_CTL) + CW_BAR + Ab->li * XCD_BAR_WORDS; bar_.x = xb_xcc_id(); bar_.st = MISC + 8; xcd_barrier(bar_, (int)threadIdx.x); } } while (0)
#if defined(PROBE_A)
#define PSCALE(k, v) ((kargs()->li == 1 && (k) == lo) ? 0.f : (v))
#else
#define PSCALE(k, v) (v)
#endif
#if defined(PROBE_A)
#define SUB(k, bit) (!(kargs()->li == 1 && (k) == lo) || ((kargs()->submask >> (bit)) & 1u))
#else
#define SUB(k, bit) true
#endif

    if (IN(0)) {
        PH_PTRS
        LAS float* scr = (LAS float*)(lds + wave * 16384);
        int rot = 0;
        for (int l = 0; l < 2; ++l) {
            unsigned char* wl = ws + WS_WL + (size_t)l * WL_STRIDE;
            cvt_mat(A->in[I_WF1I] + (size_t)l * DM * 2 * DFF, 2 * DFF, DM, 2 * DFF, (bf16*)(wl + WL_F1I), 1, 0, scr, gw, NGW, rot, lane);
            cvt_mat(A->in[I_WF1O] + (size_t)l * DFF * DM, DM, DFF, DM, (bf16*)(wl + WL_F1O), 0, 0, scr, gw, NGW, rot, lane);
            cvt_mat(A->in[I_WIN] + (size_t)l * DM * NIN, NIN, DM, 7168, (bf16*)(wl + WL_IN), 0, 0, scr, gw, NGW, rot, lane);
            cvt_mat(A->in[I_WIN] + (size_t)l * DM * NIN + 7184, NIN, DM, NIN - 7184, (bf16*)(wl + WL_IN), 0, 7168, scr, gw, NGW, rot, lane);
            cvt_mat(A->in[I_WA] + (size_t)l * 512 * DM, DM, 512, DM, (bf16*)(wl + WL_A), 0, 0, scr, gw, NGW, rot, lane, DM);
            cvt_mat(A->in[I_WB] + (size_t)l * DM * DM, DM, DM, DM, (bf16*)(wl + WL_B), 0, 0, scr, gw, NGW, rot, lane);
            cvt_mat(A->in[I_WC] + (size_t)l * DM * DM, DM, DM, DM, (bf16*)(wl + WL_C), 0, 0, scr, gw, NGW, rot, lane);
            cvt_mat(A->in[I_WO] + (size_t)l * DM * DM, DM, DM, DM, (bf16*)(wl + WL_O), 0, 0, scr, gw, NGW, rot, lane);
            cvt_mat(A->in[I_WF2I] + (size_t)l * DM * 2 * DFF, 2 * DFF, DM, 2 * DFF, (bf16*)(wl + WL_F2I), 1, 0, scr, gw, NGW, rot, lane);
            cvt_mat(A->in[I_WF2O] + (size_t)l * DFF * DM, DM, DFF, DM, (bf16*)(wl + WL_F2O), 0, 0, scr, gw, NGW, rot, lane);
            for (int hb = 0; hb < 8; ++hb) {
                cvt_mat(A->in[I_WR] + (size_t)(l * 8 + hb) * 16384, 128, 128, 128, (bf16*)(wl + WL_G), 0, hb * 256, scr, gw, NGW, rot, lane);
                cvt_mat(A->in[I_WI] + (size_t)(l * 8 + hb) * 16384, 128, 128, 128, (bf16*)(wl + WL_G), 0, hb * 256 + 128, scr, gw, NGW, rot, lane);
            }
            cvt_mat(A->in[I_WADA] + (size_t)l * DM * NMOD, NMOD, DM, NMOD, WADA, 0, l * NMOD, scr, gw, NGW, rot, lane);
        }
        for (int i = bx * 512 + tid; i < 256 * DM; i += G * 512) { const int s = i >> 10, k = i & 1023;
            float v = 0.f; if (s < 16) v = siluf_(A->in[I_CP][s * DM + k]); else if (s < NSEQ) v = siluf_(A->in[I_CS][(s - 16) * DM + k]);
            SC[i] = (bf16)f2bf(v); }
        for (int i = bx * 512 + tid; i < 24 * 129; i += G * 512) { const int gh = i / 129, j = i - gh * 129, g = gh >> 3; const int dil = g == 0 ? 1 : (g == 1 ? 4 : 16);
            const int dist = j * dil; int bucket;
            if (dist < 16) bucket = dist; else { const int lg = 16 + (int)(log((double)dist / 16.0) / log(128.0) * 16.0); bucket = lg < 31 ? lg : 31; }
            BIASG[gh * 132 + j] = A->in[I_RELB][bucket * 24 + gh]; }
        for (int i = bx * 512 + tid; i < 2 * DM; i += G * 512) ((float*)(ws + WS_SPL))[i] = -8.f * softplusf_(-A->in[I_LAM][i]);
        for (int i = bx * 512 + tid; i < 2 * 256 * DM; i += G * 512) { const int l = i / (256 * DM), r = (i >> 10) & 255, k = i & 1023;
            const float v = r < 16 ? A->in[I_WIN][(size_t)l * DM * NIN + (size_t)k * NIN + 7168 + r] : 0.f;
            ((bf16*)(ws + WS_WL + (size_t)l * WL_STRIDE + WL_IN))[(size_t)(NZ + r) * DM + k] = (bf16)f2bf(v); }
        for (int i = bx * 512 + tid; i < 2 * 3 * 256 * DM / 8; i += G * 512) ((v4u*)SHB)[i] = (v4u){0u, 0u, 0u, 0u};
    }
    SEAM(0);
    if (IN(1)) {
        PH_PTRS
        mod_small_units(lds, SC, WADA, A->in[I_BADA], MOD, SHB, tid, vcu, G);
    }
    SEAM(1);
    if (IN(2)) {
        PH_PTRS
        int rotc = 0;
#pragma unroll 1
        for (int l = 0; l < 2; ++l) {
            unsigned char* wl = ws + WS_WL + (size_t)l * WL_STRIDE;
            { pg8::Gemm g{SHB + (size_t)(l * 3 + 0) * 256 * DM, (const bf16*)(wl + WL_F1I), 256, 2 * DFF, DM, DM, DM, 0}; pg8::StaticOrder S; S.init(256, 2 * DFF, G, (bx + G - rotc % G) % G);
              pg8::EpiShw E{(float*)(ws + WS_SHW1) + (size_t)l * NSEQ * 2 * DFF, 2 * DFF}; pg8::gemm_phase<pg8::EpiShw, pg8::StaticOrder>(lds, g, S, E); rotc += 22; }
            { pg8::Gemm g{SHB + (size_t)(l * 3 + 1) * 256 * DM, (const bf16*)(wl + WL_IN), 256, NZT, DM, DM, DM, 0}; pg8::StaticOrder S; S.init(256, NZT, G, (bx + G - rotc % G) % G);
              pg8::EpiShw E{(float*)(ws + WS_SHW2) + (size_t)l * NSEQ * NZT, NZT}; pg8::gemm_phase<pg8::EpiShw, pg8::StaticOrder>(lds, g, S, E); rotc += 49; }
            { pg8::Gemm g{SHB + (size_t)(l * 3 + 2) * 256 * DM, (const bf16*)(wl + WL_F2I), 256, 2 * DFF, DM, DM, DM, 0}; pg8::StaticOrder S; S.init(256, 2 * DFF, G, (bx + G - rotc % G) % G);
              pg8::EpiShw E{(float*)(ws + WS_SHW3) + (size_t)l * NSEQ * 2 * DFF, 2 * DFF}; pg8::gemm_phase<pg8::EpiShw, pg8::StaticOrder>(lds, g, S, E); rotc += 22; }
        }
        for (int i = bx * 512 + tid; i < 2 * 3 * NSEQ * DM; i += G * 512) { const int c = i & 1023, sq = (i >> 10) % NSEQ, lk = i / (NSEQ * DM), l = lk / 3, k = lk - 3 * l;
            const float* gk = A->in[k == 0 ? I_GFF1 : (k == 1 ? I_GMIX : I_GFF2)] + l * DM;
            GAM[i] = gk[c] * (1.f + MOD[((size_t)(l * NSEQ + sq)) * NMOD + (3 * k + 1) * DM + c]); }
        { f32x4 gf[4];
#pragma unroll
          for (int j = 0; j < 4; ++j) gf[j] = *(const f32x4*)(A->in[I_GFF1] + 4 * (lane + 64 * j));
          for (int row0 = gw; row0 < M; row0 += 2 * NGW) {
            f32x4 xv[2][4], mv[2][4];
#pragma unroll
            for (int k = 0; k < 2; ++k) { const int row = row0 + k * NGW;
#pragma unroll
                for (int j = 0; j < 4; ++j) { xv[k][j] = (f32x4){0.f, 0.f, 0.f, 0.f}; mv[k][j] = (f32x4){0.f, 0.f, 0.f, 0.f}; }
                if (row < M) {
                    const float* xr = row < NPROMPT ? A->in[I_XP] + (size_t)row * DM : A->in[I_XS] + (size_t)(row - NPROMPT) * DM;
                    const float* mr = MOD + (size_t)seq_of_row(row) * NMOD + DM;
#pragma unroll
                    for (int j = 0; j < 4; ++j) { const int c = 4 * (lane + 64 * j); xv[k][j] = *(const f32x4*)(xr + c); mv[k][j] = *(const f32x4*)(mr + c); } } }
#pragma unroll
            for (int k = 0; k < 2; ++k) { const int row = row0 + k * NGW;
                if (row < M) {
                    float ss = 0.f;
#pragma unroll
                    for (int j = 0; j < 4; ++j) { const int c = 4 * (lane + 64 * j); const f32x4 v = xv[k][j];
                        ss += (v.x * v.x + v.y * v.y) + (v.z * v.z + v.w * v.w); { v2u xs_; xs_.x = pk2(v.x, v.y); xs_.y = pk2(v.z, v.w); *(v2u*)(X + (size_t)row * DM + c) = xs_; }
                        const f32x4 y = v * gf[j] * (mv[k][j] + 1.f);
                        v2u w; w.x = pk2(y.x, y.y); w.y = pk2(y.z, y.w); *(v2u*)(XB + (size_t)row * DM + c) = w; }
                    ss = wave_sum(ss);
                    if (lane < 16) SSQ[(size_t)row * 16 + lane] = lane == 0 ? ss : 0.f; } }
          } }
    }
    SEAM(2);

#pragma clang loop unroll(full)
    for (int l = 0; l < 2; ++l) {
        const int pb = PH_L0 + NPH_LAYER * l;
        if (IN(pb + 0)) {
            PH_PTRS PH_LAYER
            pg8::Gemm g{XB, (const bf16*)(wl + WL_F1I), M, 2 * DFF, DM, DM, DM, 0}; pg8::HalfOrder S; S.init(2 * DFF, G, bx);
            pg8::EpiSwiGLU E{Gb, SSQ, (const float*)(ws + WS_SHW1) + (size_t)l * NSEQ * 2 * DFF};
            pg8::gemm_phase<pg8::EpiSwiGLU, pg8::HalfOrder>(lds, g, S, E);
        }
        SEAM(pb + 0);
        if (IN(pb + 1)) {
            PH_PTRS PH_LAYER
            sample_resid_units<DFF>(lds, Gb, DFF, (const bf16*)(wl + WL_F1O), DFF, X, modl + 2 * DM, PSCALE(pb + 1, 0.5f), XB, SSQ, GAM + (size_t)(l * 3 + 1) * NSEQ * DM, tid, vcu, G);
            pg8::Gemm g{Gb, (const bf16*)(wl + WL_F1O), M, DM, DFF, DFF, DFF, 0}; pg8::StaticOrder S; S.init(NPROMPT, DM, G, bx);
            pg8::EpiResid<true> E{X, modl + 2 * DM, PSCALE(pb + 1, 0.5f), XB, SSQ, GAM + (size_t)(l * 3 + 1) * NSEQ * DM};
            pg8::gemm_phase<pg8::EpiResid<true>, pg8::StaticOrder>(lds, g, S, E);
        }
        SEAM(pb + 1);
        if (IN(pb + 2)) {
            PH_PTRS PH_LAYER
            pg8::Gemm g{XB, (const bf16*)(wl + WL_IN), M, NZT, DM, DM, DM, 0}; pg8::StaticOrder S; S.init(M, NZT, G, bx);
            pg8::EpiZ E{Z, SSQ, (const float*)(ws + WS_SHW2) + (size_t)l * NSEQ * NZT, out, DT, A->in[I_DTB] + l * 16, l};
            pg8::gemm_phase<pg8::EpiZ, pg8::StaticOrder>(lds, g, S, E);
        }
        SEAM(pb + 2);
        if (IN(pb + 3)) {
            PH_PTRS PH_LAYER
            if (SUB(pb + 3, 0)) {
                const int nitems = (M / 16) * 5;
#pragma unroll 1
                for (int it = gw; it < nitems; it += NGW) {
                    const int seg = it / 5, c = (it - seg * 5) * 64 + lane;
                    if (c >= 192 && seg * 16 < NPROMPT) continue;
                    const bool isB = c < 192; const int col = isB ? 8 * c : 8 * (c - 192); const int zc = isB ? ZXBC + col : ZXC + col; const int nch = isB ? 1536 : 1024;
                    const float* cwp = (isB ? A->in[I_CBW] + (size_t)l * 4 * 1536 : A->in[I_CCW] + (size_t)l * 4 * 1024) + col;
                    const float* cbp = (isB ? A->in[I_CBB] + (size_t)l * 1536 : A->in[I_CCB] + (size_t)l * 1024) + col;
                    float cw[4][8], cb[8];
#pragma unroll
                    for (int e = 0; e < 8; ++e) { cb[e] = cbp[e];
#pragma unroll
                        for (int j = 0; j < 4; ++j) cw[j][e] = cwp[j * nch + e]; }
                    const int r0 = seg * 16; const bool isS = r0 >= NPROMPT; const int t0 = isS ? 0 : (r0 & (SEQ - 1));
                    float win[3][8];
#pragma unroll
                    for (int j = 0; j < 3; ++j) {
                        if (!isS && t0 >= 3) { unpack8(*(const v4u*)ZP(Z, r0 - 3 + j, zc), win[j]); }
                        else {
#pragma unroll
                            for (int e = 0; e < 8; ++e) win[j][e] = 0.f; } }
                    v4u rw[16];
#pragma unroll
                    for (int i = 0; i < 16; ++i) rw[i] = *(const v4u*)ZP(Z, r0 + i, zc);
#pragma unroll
                    for (int i = 0; i < 16; ++i) { const int row = r0 + i; const int t = isS ? (i & 7) : t0 + i;
                        float cur[8]; unpack8(rw[i], cur);
                        if (isS && t < 3) {
                            const float* st = (isB ? A->in[I_SCB] + (size_t)(l * 32 + ((row - NPROMPT) >> 3)) * 3 * 1536 : A->in[I_SCC] + (size_t)(l * 32 + ((row - NPROMPT) >> 3)) * 3 * 1024) + col;
#pragma unroll
                            for (int j = 0; j < 3; ++j) { const int tt = t - 3 + j;
                                if (tt < 0) {
#pragma unroll
                                    for (int e = 0; e < 8; ++e) win[j][e] = st[(size_t)(3 + tt) * nch + e]; } } }
                        float a8[8];
#pragma unroll
                        for (int e = 0; e < 8; ++e) { a8[e] = cb[e] + cw[0][e] * win[0][e] + cw[1][e] * win[1][e] + cw[2][e] * win[2][e] + cw[3][e] * cur[e];
                            win[0][e] = win[1][e]; win[1][e] = win[2][e]; win[2][e] = cur[e]; }
                        if (isB) {
#pragma unroll
                            for (int e = 0; e < 8; ++e) a8[e] = siluf_(a8[e]);
                            *(v4u*)(XBCV + (size_t)row * 1536 + col) = pack8(a8); }
                        else *(v4u*)(XCV + (size_t)row * DM + col) = pack8(a8);
                    }
                }
            }
            if (SUB(pb + 3, 1)) {
                LAS unsigned char* KB0 = lds; LAS unsigned char* VB0 = lds + 65536; LAS float* bsm = (LAS float*)(lds + 131072);
                const int qq = lane & 15, q4 = lane >> 4, w = wave;
                constexpr int NUN = 16 * 3 * 8 * 16;
#define ATT_DECODE(un_) const int blk = (un_) & 15, hh = ((un_) >> 4) & 7, g = ((un_) >> 7) % 3, b = (un_) / 384; \
                    const int dil = g == 0 ? 1 : (g == 1 ? 4 : 16), nbr = 16 / dil, r = blk / nbr, qb = blk - r * nbr, i0 = qb * 128; const size_t rowb = (size_t)b * SEQ;
#define ATT_ISSUE(un_, bi_, qdst) do { ATT_DECODE(un_) \
                    _Pragma("unroll") for (int k = 0; k < 4; ++k) { const int rb = k * 8 + w, row = 8 * rb + (lane >> 3), ch = (lane & 7) ^ (row & 7); int si = i0 - 128 + row; si = si < 0 ? 0 : si; \
                        const size_t zr_ = rowb + (size_t)si * dil + r; const int zc_ = g * 512 + hh * 64 + ch * 8; \
                        __builtin_amdgcn_global_load_lds((const unsigned*)ZP(Z, zr_, ZK + zc_), (LAS unsigned*)(KB0 + (bi_) * 32768 + rb * 1024), 16, 0, 0); \
                        __builtin_amdgcn_global_load_lds((const unsigned*)ZP(Z, zr_, ZV + zc_), (LAS unsigned*)(VB0 + (bi_) * 32768 + rb * 1024), 16, 0, 0); } \
                    { const bf16* qp = ZP(Z, rowb + (size_t)(i0 + 16 * w + qq) * dil + r, ZQ + g * 512 + hh * 64 + 8 * q4); qdst[0] = *(const bf16x8*)qp; qdst[1] = *(const bf16x8*)(qp + 32); } \
                    bnx = 0.f; if (tid < 129) bnx = BIASG[(g * 8 + hh) * 132 + tid]; } while (0)
                bf16x8 qn[2] = {(bf16x8){0, 0, 0, 0, 0, 0, 0, 0}, (bf16x8){0, 0, 0, 0, 0, 0, 0, 0}}; float bnx = 0.f;
                __syncthreads();
                if (vcu < NUN) ATT_ISSUE(vcu, 0, qn);
                int it = 0;
                for (int un = vcu; un < NUN; un += G, ++it) {
                    ATT_DECODE(un)
                    const int bi = it & 1;
                    if (it == 0) asm volatile("s_waitcnt vmcnt(0)" ::: "memory");
                    else asm volatile("s_waitcnt vmcnt(4)" ::: "memory");
                    if (tid < 129) bsm[bi * 132 + tid] = bnx;
                    asm volatile("s_waitcnt lgkmcnt(0)\n\ts_barrier" ::: "memory");
                    bf16x8 qf[2]; qf[0] = qn[0]; qf[1] = qn[1];
                    if (un + G < NUN) ATT_ISSUE(un + G, bi ^ 1, qn);
                    const LAS unsigned char* Kb = KB0 + bi * 32768; const LAS unsigned char* Vb = VB0 + bi * 32768; const LAS float* bias = bsm + bi * 132;
                    f32x4 sacc[9];
#pragma unroll
                    for (int kr = 0; kr < 9; ++kr) sacc[kr] = (f32x4){0.f, 0.f, 0.f, 0.f};
                    { bf16x8 kf[9][2];
#pragma unroll
                      for (int kr = 0; kr < 9; ++kr) { const int row = 16 * (w + kr) + qq;
#pragma unroll
                          for (int s2 = 0; s2 < 2; ++s2) kf[kr][s2] = *(const LAS bf16x8*)(Kb + row * 128 + (((4 * s2 + q4) ^ (row & 7)) << 4)); }
#pragma unroll
                      for (int kr = 0; kr < 9; ++kr)
#pragma unroll
                          for (int s2 = 0; s2 < 2; ++s2) sacc[kr] = __builtin_amdgcn_mfma_f32_16x16x32_bf16(kf[kr][s2], qf[s2], sacc[kr], 0, 0, 0); }
                    float mx = -INFINITY;
#pragma unroll
                    for (int kr = 0; kr < 9; ++kr)
#pragma unroll
                        for (int i = 0; i < 4; ++i) { const int dist = 128 + qq - 16 * kr - 4 * q4 - i; const int si = i0 - 128 + 16 * (w + kr) + 4 * q4 + i;
                            const bool valid = dist >= 0 && dist <= 128 && si >= 0;
                            const float bv = bias[dist < 0 ? 0 : (dist > 128 ? 128 : dist)];
                            const float lgu = sacc[kr][i] * 0.125f + bv; const float lg = valid ? lgu : -INFINITY; sacc[kr][i] = lg; mx = fmaxf(mx, lg); }
                    mx = fmaxf(mx, __shfl_xor(mx, 16)); mx = fmaxf(mx, __shfl_xor(mx, 32));
                    float sm = 0.f;
#pragma unroll
                    for (int kr = 0; kr < 9; ++kr)
#pragma unroll
                        for (int i = 0; i < 4; ++i) { const float p = __expf(sacc[kr][i] - mx); sacc[kr][i] = p; sm += p; }
                    sm += __shfl_xor(sm, 16); sm += __shfl_xor(sm, 32);
                    f32x4 oacc[4];
#pragma unroll
                    for (int dt = 0; dt < 4; ++dt) oacc[dt] = (f32x4){0.f, 0.f, 0.f, 0.f};
                    typedef short v4i16_t __attribute__((ext_vector_type(4)));
#pragma unroll
                    for (int st = 0; st < 5; ++st) {
                        const int ka = 2 * st, kb2 = (2 * st + 1 < 9) ? 2 * st + 1 : 2 * st;
                        v4u pw; pw.x = pk2(sacc[ka][0], sacc[ka][1]); pw.y = pk2(sacc[ka][2], sacc[ka][3]);
                        if (2 * st + 1 < 9) { pw.z = pk2(sacc[kb2][0], sacc[kb2][1]); pw.w = pk2(sacc[kb2][2], sacc[kb2][3]); } else { pw.z = 0u; pw.w = 0u; }
                        const bf16x8 pf = __builtin_bit_cast(bf16x8, pw);
                        const int rwa = 16 * (w + ka) + 4 * q4 + (qq >> 2), rwb = 16 * (w + kb2) + 4 * q4 + (qq >> 2);
#pragma unroll
                        for (int dt = 0; dt < 4; ++dt) { const int chv = 2 * dt + ((qq & 3) >> 1);
                            const v2u lo2 = __builtin_bit_cast(v2u, __builtin_amdgcn_ds_read_tr16_b64_v4i16((LAS v4i16_t*)(Vb + rwa * 128 + ((chv ^ (rwa & 7)) << 4) + 8 * (qq & 1))));
                            const v2u hi2 = __builtin_bit_cast(v2u, __builtin_amdgcn_ds_read_tr16_b64_v4i16((LAS v4i16_t*)(Vb + rwb * 128 + ((chv ^ (rwb & 7)) << 4) + 8 * (qq & 1))));
                            v4u vw; vw.x = lo2.x; vw.y = lo2.y; vw.z = hi2.x; vw.w = hi2.y;
                            oacc[dt] = __builtin_amdgcn_mfma_f32_16x16x32_bf16(__builtin_bit_cast(bf16x8, vw), pf, oacc[dt], 0, 0, 0); }
                    }
                    const float inv = rcpf_(sm);
                    const size_t orow = rowb + (size_t)(i0 + 16 * w + qq) * dil + r;
                    bf16* op = OG + ((size_t)g * M + orow) * 512 + hh * 64 + 4 * q4;
#pragma unroll
                    for (int dt = 0; dt < 4; ++dt) { v2u ow; ow.x = pk2(oacc[dt][0] * inv, oacc[dt][1] * inv); ow.y = pk2(oacc[dt][2] * inv, oacc[dt][3] * inv); *(v2u*)(op + 16 * dt) = ow; }
                    if (q4 == 0) LSE[((size_t)g * M + orow) * 8 + hh] = mx + __logf(sm);
                }
                asm volatile("s_waitcnt vmcnt(0) lgkmcnt(0)" ::: "memory");
                __syncthreads();
            }
            if (SUB(pb + 3, 2)) {
                LAS float* pbuf = (LAS float*)(lds + 98304) + wave * 136;
                for (int un = gw; un < 32 * 8 * 3 * 8; un += NGW) {
                    const int hh = un & 7, g = (un >> 3) % 3, t = (un / 24) & 7, sb = un / 192;
                    const int dil = g == 0 ? 1 : (g == 1 ? 4 : 16), wb = g == 0 ? 128 : (g == 1 ? 512 : 2048);
                    const float* cache = A->in[g == 0 ? I_KV1 : (g == 1 ? I_KV2 : I_KV3)] + (size_t)(l * 32 + sb) * wb * 1024;
                    const size_t rowS = (size_t)NPROMPT + sb * 8;
                    const bf16* qp = ZP(Z, rowS + t, ZQ + g * 512 + hh * 64);
                    float q[64];
#pragma unroll
                    for (int c = 0; c < 8; ++c) { float tmp[8]; unpack8(*(const v4u*)(qp + 8 * c), tmp);
#pragma unroll
                        for (int e = 0; e < 8; ++e) q[8 * c + e] = tmp[e]; }
                    const float* bias = BIASG + (g * 8 + hh) * 132;
                    float sc3[3] = {-INFINITY, -INFINITY, -INFINITY};
#pragma unroll 1
                    for (int jj = 0; jj < 3; ++jj) { const int j = 64 * jj + lane; float s = -INFINITY;
                        if (j <= 128) { const int idx = wb + t - dil * j; float d = 0.f;
                            if (idx >= wb) { const bf16* kp = ZP(Z, rowS + (idx - wb), ZK + g * 512 + hh * 64);
#pragma unroll
                                for (int c = 0; c < 8; ++c) { float tmp[8]; unpack8(*(const v4u*)(kp + 8 * c), tmp);
#pragma unroll
                                    for (int e = 0; e < 8; ++e) d += q[8 * c + e] * tmp[e]; } }
                            else { const float* kp = cache + (size_t)idx * 1024 + hh * 64;
#pragma unroll
                                for (int c = 0; c < 16; ++c) { const f32x4 k4 = *(const f32x4*)(kp + 4 * c); d += (q[4 * c] * k4.x + q[4 * c + 1] * k4.y) + (q[4 * c + 2] * k4.z + q[4 * c + 3] * k4.w); } }
                            s = d * 0.125f + bias[j]; }
                        sc3[0] = jj == 0 ? s : sc3[0]; sc3[1] = jj == 1 ? s : sc3[1]; sc3[2] = jj == 2 ? s : sc3[2]; }
                    const float mx = wave_max(fmaxf(fmaxf(sc3[0], sc3[1]), sc3[2]));
                    float sm = 0.f;
#pragma unroll
                    for (int jj = 0; jj < 3; ++jj) { const int j = 64 * jj + lane; const float p = (j <= 128) ? __expf(sc3[jj] - mx) : 0.f; sm += p; if (j <= 128) pbuf[j] = p; }
                    sm = wave_sum(sm);
                    LDS_WAIT(); asm volatile("" ::: "memory");
                    float o = 0.f;
                    const int jn = t / dil + 1;
                    for (int j = 0; j < jn; ++j) o += pbuf[j] * bf2f(*ZP(Z, rowS + (t - dil * j), ZV + g * 512 + hh * 64 + lane));
                    { const float* vc = cache + (size_t)(wb + t) * 1024 + 512 + hh * 64 + lane; const size_t vstep = (size_t)dil * 1024;
#pragma unroll 8
                      for (int j = jn; j <= 128; ++j) o += pbuf[j] * vc[-(ptrdiff_t)(j * vstep)]; }
                    OG[((size_t)g * M + rowS + t) * 512 + hh * 64 + lane] = (bf16)f2bf(o * rcpf_(sm));
                    if (lane == 0) LSE[((size_t)g * M + rowS + t) * 8 + hh] = mx + __logf(sm);
                    LDS_WAIT(); asm volatile("" ::: "memory");
                }
                __syncthreads();
            }
        }
        SEAM(pb + 3);
        if (IN(pb + 4)) {
            PH_PTRS PH_LAYER
            if (SUB(pb + 4, 0)) {
                const bf16* wg = (const bf16*)(wl + WL_G); const int qq = lane & 15, q4 = lane >> 4;
                for (int un = gw; un < 16 * 8 * 4; un += NGW) {
                    const int rt = un >> 5, j = (un >> 2) & 7, qd = un & 3, ch0 = j * 128 + 32 * qd;
                    const bf16* ap = XCV + ((size_t)NPROMPT + 16 * rt + qq) * DM + j * 128 + 8 * q4;
                    f32x4 ga[4];
#pragma unroll
                    for (int ct = 0; ct < 4; ++ct) ga[ct] = (f32x4){0.f, 0.f, 0.f, 0.f};
#pragma unroll
                    for (int ks = 0; ks < 4; ++ks) { const bf16x8 xf = *(const bf16x8*)(ap + 32 * ks);
#pragma unroll
                        for (int ct = 0; ct < 4; ++ct) { const int wrow = j * 256 + (ct >> 1) * 128 + 32 * qd + 16 * (ct & 1) + qq;
                            ga[ct] = __builtin_amdgcn_mfma_f32_16x16x32_bf16(*(const bf16x8*)(wg + (size_t)wrow * 128 + 32 * ks + 8 * q4), xf, ga[ct], 0, 0, 0); } }
#pragma unroll
                    for (int h2 = 0; h2 < 2; ++h2) { const int ch = ch0 + 16 * h2 + 4 * q4; const size_t row = (size_t)16 * rt + qq;
                        const f32x4 brv = *(const f32x4*)(A->in[I_BR] + l * DM + ch), biv = *(const f32x4*)(A->in[I_BI] + l * DM + ch), sp = *(const f32x4*)((const float*)(ws + WS_SPL) + l * DM + ch);
                        const v2u xw = *(const v2u*)(XCV + ((size_t)NPROMPT + row) * DM + ch); const float xv[4] = {bflo(xw.x), bfhi(xw.x), bflo(xw.y), bfhi(xw.y)};
                        f32x4 av, uv;
#pragma unroll
                        for (int i = 0; i < 4; ++i) { const float rg = sigmoidf_(ga[h2][i] + brv[i]), ig = sigmoidf_(ga[2 + h2][i] + biv[i]); const float la = sp[i] * rg;
                            av[i] = __expf(la); uv[i] = xv[i] * ig * __builtin_amdgcn_sqrtf(one_minus_exp(2.f * la)); }
                        *(f32x4*)(AL + row * DM + ch) = av; *(f32x4*)(U + row * DM + ch) = uv; }
                }
            }
            __syncthreads();
            if (SUB(pb + 4, 1)) {
                constexpr int ST = 136, SX = 72;
                LAS bf16* xs = (LAS bf16*)lds;
                LAS bf16* Bsm = xs + 128 * SX;
                LAS bf16* Bw = Bsm + 128 * ST;
                LAS bf16* Csm = Bw + 128 * ST;
                LAS bf16* hT = Csm + 128 * ST;
                LAS float* acum = (LAS float*)(hT + 128 * SX);
                LAS float* dtl = acum + 128;
                static_assert((128 * SX * 2 + 3 * 128 * ST) * 2 + 1024 <= LDSCTL_OFF, "SSD LDS map");
                const int qq = lane & 15, q4 = lane >> 4, w = wave, lrow = 16 * w + qq;
                for (int un = vcu; un < 256; un += G) {
                    const int b = un >> 4, hd = un & 15, gq = hd >> 3;
                    const float aneg = -__expf(A->in[I_ALOG][l * 16 + hd]), Dsk = A->in[I_DSKIP][l * 16 + hd];
                    f32x4 hacc[4];
#pragma unroll
                    for (int pt = 0; pt < 4; ++pt) hacc[pt] = (f32x4){0.f, 0.f, 0.f, 0.f};
#define SSD_LOAD(c_) do { const size_t r0_ = (size_t)b * SEQ + 128 * (c_); \
                        _Pragma("unroll") for (int k = 0; k < 2; ++k) { const int idx = tid + 512 * k, s_ = idx >> 3, part = idx & 7; xr[k] = *(const v4u*)(XBCV + (r0_ + s_) * 1536 + hd * 64 + part * 8); } \
                        _Pragma("unroll") for (int k = 0; k < 4; ++k) { const int idx = tid + 512 * k, s_ = idx >> 4, part = idx & 15; const bf16* bp = XBCV + (r0_ + s_) * 1536 + 1024 + gq * 128 + part * 8; \
                            br[k] = *(const v4u*)bp; cr[k] = *(const v4u*)(bp + 256); } \
                        dtv = 0.f; if (tid < 128) dtv = DT[(r0_ + tid) * 16 + hd]; } while (0)
                    v4u xr[2] = {(v4u){0u, 0u, 0u, 0u}, (v4u){0u, 0u, 0u, 0u}}, br[4] = {(v4u){0u, 0u, 0u, 0u}, (v4u){0u, 0u, 0u, 0u}, (v4u){0u, 0u, 0u, 0u}, (v4u){0u, 0u, 0u, 0u}}, cr[4] = {(v4u){0u, 0u, 0u, 0u}, (v4u){0u, 0u, 0u, 0u}, (v4u){0u, 0u, 0u, 0u}, (v4u){0u, 0u, 0u, 0u}}; float dtv = 0.f;
                    SSD_LOAD(0);
#pragma unroll 1
                    for (int c = 0; c < 16; ++c) {
                        const size_t r0 = (size_t)b * SEQ + 128 * c;
                        LBAR();
                        if (tid < 128) dtl[tid] = dtv;
#pragma unroll
                        for (int pt = 0; pt < 4; ++pt) { v2u hw; hw.x = pk2(hacc[pt][0], hacc[pt][1]); hw.y = pk2(hacc[pt][2], hacc[pt][3]); *(LAS v2u*)(hT + lrow * SX + 16 * pt + 4 * q4) = hw; }
#pragma unroll
                        for (int k = 0; k < 2; ++k) { const int idx = tid + 512 * k, s_ = idx >> 3, part = idx & 7; *(LAS v4u*)(xs + s_ * SX + part * 8) = xr[k]; }
#pragma unroll
                        for (int k = 0; k < 4; ++k) { const int idx = tid + 512 * k, s_ = idx >> 4, part = idx & 15; *(LAS v4u*)(Bsm + s_ * ST + part * 8) = br[k]; *(LAS v4u*)(Csm + s_ * ST + part * 8) = cr[k]; }
                        LBAR();
                        if (w == 0) { const float a0 = dtl[2 * lane] * aneg, a1 = dtl[2 * lane + 1] * aneg; const float sp = a0 + a1; float v = sp;
#pragma unroll
                            for (int o = 1; o < 64; o <<= 1) { const float t = __shfl_up(v, o); if (lane >= o) v += t; }
                            acum[2 * lane] = v - sp + a0; acum[2 * lane + 1] = v; }
                        LBAR();
                        const float alast = acum[127];
#pragma unroll
                        for (int k = 0; k < 4; ++k) { const int idx = tid + 512 * k, s_ = idx >> 4, part = idx & 15; const float wg = dtl[s_] * __expf(alast - acum[s_]);
                            float bv[8]; unpack8(br[k], bv);
#pragma unroll
                            for (int e = 0; e < 8; ++e) bv[e] *= wg;
                            *(LAS v4u*)(Bw + s_ * ST + part * 8) = pack8(bv); }
                        if (c < 15) SSD_LOAD(c + 1);
                        LBAR();
                        bf16x8 cf[4];
#pragma unroll
                        for (int ks = 0; ks < 4; ++ks) cf[ks] = *(const LAS bf16x8*)(Csm + lrow * ST + 32 * ks + 8 * q4);
                        f32x4 yacc[4];
#pragma unroll
                        for (int pt = 0; pt < 4; ++pt) { yacc[pt] = (f32x4){0.f, 0.f, 0.f, 0.f};
#pragma unroll
                            for (int ks = 0; ks < 4; ++ks) { const v2u a0 = tr_read(hT, SX, 32 * ks + 8 * q4, 16 * pt, qq), a1 = tr_read(hT, SX, 32 * ks + 8 * q4 + 4, 16 * pt, qq);
                                v4u aw; aw.x = a0.x; aw.y = a0.y; aw.z = a1.x; aw.w = a1.y; yacc[pt] = __builtin_amdgcn_mfma_f32_16x16x32_bf16(__builtin_bit_cast(bf16x8, aw), cf[ks], yacc[pt], 0, 0, 0); } }
                        const float al = acum[lrow], el = __expf(al);
#pragma unroll
                        for (int pt = 0; pt < 4; ++pt) yacc[pt] = yacc[pt] * el;
                        f32x4 cb[8];
#pragma unroll
                        for (int st = 0; st < 8; ++st) { cb[st] = (f32x4){0.f, 0.f, 0.f, 0.f};
                            if (st <= w) {
#pragma unroll
                                for (int ks = 0; ks < 4; ++ks) { const bf16x8 bfa = *(const LAS bf16x8*)(Bsm + (16 * st + qq) * ST + 32 * ks + 8 * q4); cb[st] = __builtin_amdgcn_mfma_f32_16x16x32_bf16(bfa, cf[ks], cb[st], 0, 0, 0); }
                                const f32x4 as4 = *(const LAS f32x4*)(acum + 16 * st + 4 * q4), ds4 = *(const LAS f32x4*)(dtl + 16 * st + 4 * q4);
#pragma unroll
                                for (int i = 0; i < 4; ++i) { const bool valid = (16 * st + 4 * q4 + i) <= lrow; const float dd = valid ? al - as4[i] : 0.f; cb[st][i] = valid ? cb[st][i] * __expf(dd) * ds4[i] : 0.f; } } }
#pragma unroll
                        for (int j = 0; j < 4; ++j) if (2 * j <= w) {
                            v4u pw; pw.x = pk2(cb[2 * j][0], cb[2 * j][1]); pw.y = pk2(cb[2 * j][2], cb[2 * j][3]); pw.z = pk2(cb[2 * j + 1][0], cb[2 * j + 1][1]); pw.w = pk2(cb[2 * j + 1][2], cb[2 * j + 1][3]);
                            const bf16x8 pf = __builtin_bit_cast(bf16x8, pw);
#pragma unroll
                            for (int pt = 0; pt < 4; ++pt) { const v2u lo2 = tr_read(xs, SX, 32 * j + 4 * q4, 16 * pt, qq), hi2 = tr_read(xs, SX, 32 * j + 16 + 4 * q4, 16 * pt, qq);
                                v4u xw; xw.x = lo2.x; xw.y = lo2.y; xw.z = hi2.x; xw.w = hi2.y;
                                yacc[pt] = __builtin_amdgcn_mfma_f32_16x16x32_bf16(__builtin_bit_cast(bf16x8, xw), pf, yacc[pt], 0, 0, 0); } }
                        { const size_t row = r0 + lrow;
#pragma unroll
                          for (int pt = 0; pt < 4; ++pt) { const v2u xg = *(const v2u*)(XBCV + row * 1536 + hd * 64 + 16 * pt + 4 * q4);
                              f32x4 y = yacc[pt]; y.x += Dsk * bflo(xg.x); y.y += Dsk * bfhi(xg.x); y.z += Dsk * bflo(xg.y); y.w += Dsk * bfhi(xg.y);
                              v2u yw; yw.x = pk2(y.x, y.y); yw.y = pk2(y.z, y.w); *(v2u*)(YS + row * DM + hd * 64 + 16 * pt + 4 * q4) = yw; } }
                        { const float elast = __expf(alast);
#pragma unroll
                          for (int pt = 0; pt < 4; ++pt) hacc[pt] = hacc[pt] * elast;
#pragma unroll
                          for (int ks = 0; ks < 4; ++ks) { const v2u b0 = tr_read(Bw, ST, 32 * ks + 8 * q4, 16 * w, qq), b1 = tr_read(Bw, ST, 32 * ks + 8 * q4 + 4, 16 * w, qq);
                              v4u bw; bw.x = b0.x; bw.y = b0.y; bw.z = b1.x; bw.w = b1.y; const bf16x8 bfb = __builtin_bit_cast(bf16x8, bw);
#pragma unroll
                              for (int pt = 0; pt < 4; ++pt) { const v2u a0 = tr_read(xs, SX, 32 * ks + 8 * q4, 16 * pt, qq), a1 = tr_read(xs, SX, 32 * ks + 8 * q4 + 4, 16 * pt, qq);
                                  v4u aw; aw.x = a0.x; aw.y = a0.y; aw.z = a1.x; aw.w = a1.y; hacc[pt] = __builtin_amdgcn_mfma_f32_16x16x32_bf16(__builtin_bit_cast(bf16x8, aw), bfb, hacc[pt], 0, 0, 0); } } }
                    }
                    float* ho = out + O_PSSM + ((size_t)(l * 16 + b) * 16 + hd) * 8192;
#pragma unroll
                    for (int pt = 0; pt < 4; ++pt)
#pragma unroll
                        for (int i = 0; i < 4; ++i) ho[(16 * pt + 4 * q4 + i) * 128 + lrow] = hacc[pt][i];
                }
                __syncthreads();
            }
            if (SUB(pb + 4, 2)) {
                LAS float* xs = (LAS float*)lds; LAS float* Bs = xs + 64 * 64; LAS float* Cs = Bs + 64 * 128; LAS float* dts = Cs + 64 * 128; LAS float* decs = dts + 64; LAS float* ysb = decs + 64;
                const int p = tid >> 3, ng = tid & 7, n0 = 16 * ng;
                for (int un = 256 + vcu; un < 256 + 512; un += G) {
                    const bool isS = un >= 256; const int sq = isS ? (un - 256) >> 4 : un >> 4, hd = un & 15, gq = hd >> 3;
                    const int L = isS ? 8 : SEQ; const size_t row0 = isS ? (size_t)NPROMPT + sq * 8 : (size_t)sq * SEQ;
                    float hst[16];
                    if (isS) { const float* h0 = A->in[I_SSSM] + ((size_t)(l * 32 + sq) * 16 + hd) * 8192 + p * 128 + n0;
#pragma unroll
                        for (int i = 0; i < 16; ++i) hst[i] = h0[i]; }
                    else {
#pragma unroll
                        for (int i = 0; i < 16; ++i) hst[i] = 0.f; }
                    const float aneg = -__expf(A->in[I_ALOG][l * 16 + hd]), Dsk = A->in[I_DSKIP][l * 16 + hd];
                    for (int t0 = 0; t0 < L; t0 += 64) {
                        const int tc = (L - t0) < 64 ? (L - t0) : 64;
                        __syncthreads();
                        for (int c = tid; c < tc * 40; c += 512) { const int tok = c / 40, part = c - tok * 40;
                            const int col = part < 8 ? hd * 64 + part * 8 : (part < 24 ? 1024 + gq * 128 + (part - 8) * 8 : 1280 + gq * 128 + (part - 24) * 8);
                            float tmp[8]; unpack8(*(const v4u*)(XBCV + (row0 + t0 + tok) * 1536 + col), tmp);
                            LAS float* d = part < 8 ? xs + tok * 64 + part * 8 : (part < 24 ? Bs + tok * 128 + (part - 8) * 8 : Cs + tok * 128 + (part - 24) * 8);
                            *(LAS f32x4*)d = (f32x4){tmp[0], tmp[1], tmp[2], tmp[3]}; *(LAS f32x4*)(d + 4) = (f32x4){tmp[4], tmp[5], tmp[6], tmp[7]}; }
                        if (tid < tc) { const float dtv = DT[(row0 + t0 + tid) * 16 + hd]; dts[tid] = dtv; decs[tid] = __expf(dtv * aneg); }
                        __syncthreads();
                        for (int t = 0; t < tc; ++t) {
                            const float xv = xs[t * 64 + p], dec = decs[t], dtx = dts[t] * xv;
                            float accy = 0.f;
#pragma unroll
                            for (int i4 = 0; i4 < 4; ++i4) { const f32x4 b4 = *(const LAS f32x4*)(Bs + t * 128 + n0 + 4 * i4), c4 = *(const LAS f32x4*)(Cs + t * 128 + n0 + 4 * i4);
#pragma unroll
                                for (int e = 0; e < 4; ++e) { hst[4 * i4 + e] = dec * hst[4 * i4 + e] + dtx * b4[e]; accy += hst[4 * i4 + e] * c4[e]; } }
                            accy += __shfl_xor(accy, 1); accy += __shfl_xor(accy, 2); accy += __shfl_xor(accy, 4);
                            if (ng == 0) ysb[t * 64 + p] = accy + Dsk * xv;
                        }
                        __syncthreads();
                        for (int e = tid; e < tc * 64; e += 512) { const int tok = e >> 6, pp = e & 63; YS[(row0 + t0 + tok) * DM + hd * 64 + pp] = (bf16)f2bf(ysb[e]); }
                    }
                    float* ho = out + (isS ? O_SSSM + ((size_t)(l * 32 + sq) * 16 + hd) * 8192 : O_PSSM + ((size_t)(l * 16 + sq) * 16 + hd) * 8192) + p * 128 + n0;
#pragma unroll
                    for (int i4 = 0; i4 < 4; ++i4) *(f32x4*)(ho + 4 * i4) = (f32x4){hst[4 * i4], hst[4 * i4 + 1], hst[4 * i4 + 2], hst[4 * i4 + 3]};
                }
                __syncthreads();
            }
        }
        SEAM(pb + 4);
        if (IN(pb + 5)) {
            PH_PTRS PH_LAYER
            if (SUB(pb + 5, 0)) {
                constexpr int LT = 136, AS = 68;
                LAS bf16* Xs = (LAS bf16*)lds;
                LAS bf16* Ws = Xs + 128 * LT;
                LAS float* As = (LAS float*)(Ws + 128 * LT);
                LAS float* Us = As + 128 * AS;
                LAS float* sP = Us + 128 * AS;
                LAS float* sH = sP + 512;
                LAS float* cS = sH + 512;
                LAS float* cst = cS + 128;
                static_assert(2 * 128 * LT * 2 + (2 * 128 * AS + 512 + 512 + 128 + 192) * 4 <= LDSCTL_OFF, "LRU LDS map");
                const int qq = lane & 15, q4 = lane >> 4, w = wave;
                for (int un = vcu; un < 256; un += G) {
                    const int b = un >> 4, j = (un >> 1) & 7, h2 = un & 1, chb = j * 128 + 64 * h2;
                    __syncthreads();
                    { const bf16* wg = (const bf16*)(wl + WL_G);
#pragma unroll
                      for (int k = 0; k < 4; ++k) { const int idx = tid + 512 * k, n = idx >> 4, part = idx & 15; const int srow = j * 256 + (n < 64 ? 64 * h2 + n : 128 + 64 * h2 + (n - 64));
                          *(LAS v4u*)(Ws + n * LT + part * 8) = *(const v4u*)(wg + (size_t)srow * 128 + part * 8); }
                      if (tid < 64) { cst[tid] = A->in[I_BR][l * DM + chb + tid]; cst[64 + tid] = A->in[I_BI][l * DM + chb + tid]; cst[128 + tid] = ((const float*)(ws + WS_SPL))[l * DM + chb + tid]; cS[tid] = 0.f; } }
                    const int cpart = tid & 15, ctb = 4 * (tid >> 4);
                    float cwv[4][8], cbv[8];
#pragma unroll
                    for (int e = 0; e < 8; ++e) { cbv[e] = A->in[I_CCB][l * DM + j * 128 + cpart * 8 + e];
#pragma unroll
                        for (int jj = 0; jj < 4; ++jj) cwv[jj][e] = A->in[I_CCW][(size_t)(l * 4 + jj) * DM + j * 128 + cpart * 8 + e]; }
                    v4u xr[7] = {(v4u){0u, 0u, 0u, 0u}, (v4u){0u, 0u, 0u, 0u}, (v4u){0u, 0u, 0u, 0u}, (v4u){0u, 0u, 0u, 0u}, (v4u){0u, 0u, 0u, 0u}, (v4u){0u, 0u, 0u, 0u}, (v4u){0u, 0u, 0u, 0u}};
#define LRU_LOAD(tile_) do { const int tb_ = 128 * (tile_) + ctb - 3; \
                        _Pragma("unroll") for (int k = 0; k < 7; ++k) { xr[k] = (v4u){0u, 0u, 0u, 0u}; if (tb_ + k >= 0) xr[k] = *(const v4u*)ZP(Z, (size_t)b * SEQ + tb_ + k, ZXC + j * 128 + cpart * 8); } } while (0)
                    LRU_LOAD(0);
#pragma unroll 1
                    for (int tile = 0; tile < 16; ++tile) {
                        const size_t r0 = (size_t)b * SEQ + 128 * tile;
                        LBAR();
                        { float xf7[7][8];
#pragma unroll
                          for (int k = 0; k < 7; ++k) unpack8(xr[k], xf7[k]);
#pragma unroll
                          for (int k = 0; k < 4; ++k) { float o8[8];
#pragma unroll
                              for (int e = 0; e < 8; ++e) o8[e] = cbv[e] + cwv[0][e] * xf7[k][e] + cwv[1][e] * xf7[k + 1][e] + cwv[2][e] * xf7[k + 2][e] + cwv[3][e] * xf7[k + 3][e];
                              *(LAS v4u*)(Xs + (ctb + k) * LT + cpart * 8) = pack8(o8); } }
                        if (tile < 15) LRU_LOAD(tile + 1);
                        v4u gcr[2];
#pragma unroll
                        for (int k = 0; k < 2; ++k) { const int idx = tid + 512 * k, t_ = idx >> 3, part = idx & 7; gcr[k] = *(const v4u*)ZP(Z, r0 + t_, ZGC + chb + part * 8); }
                        LBAR();
                        { bf16x8 xf[4];
#pragma unroll
                          for (int ks = 0; ks < 4; ++ks) xf[ks] = *(const LAS bf16x8*)(Xs + (16 * w + qq) * LT + 32 * ks + 8 * q4);
                          f32x4 ga[8];
#pragma unroll
                          for (int nt = 0; nt < 8; ++nt) { ga[nt] = (f32x4){0.f, 0.f, 0.f, 0.f};
#pragma unroll
                              for (int ks = 0; ks < 4; ++ks) { const bf16x8 wf = *(const LAS bf16x8*)(Ws + (16 * nt + qq) * LT + 32 * ks + 8 * q4); ga[nt] = __builtin_amdgcn_mfma_f32_16x16x32_bf16(wf, xf[ks], ga[nt], 0, 0, 0); } }
#pragma unroll
                          for (int nt = 0; nt < 4; ++nt) { const int c0 = 16 * nt + 4 * q4;
                              const f32x4 brv = *(const LAS f32x4*)(cst + c0), biv = *(const LAS f32x4*)(cst + 64 + c0), spv = *(const LAS f32x4*)(cst + 128 + c0);
                              const v2u xw = *(const LAS v2u*)(Xs + (16 * w + qq) * LT + 64 * h2 + c0); const float xv[4] = {bflo(xw.x), bfhi(xw.x), bflo(xw.y), bfhi(xw.y)};
                              f32x4 av, uv;
#pragma unroll
                              for (int i = 0; i < 4; ++i) { const float rg = sigmoidf_(ga[nt][i] + brv[i]), ig = sigmoidf_(ga[nt + 4][i] + biv[i]); const float la = spv[i] * rg;
                                  av[i] = __expf(la); uv[i] = xv[i] * ig * __builtin_amdgcn_sqrtf(one_minus_exp(2.f * la)); }
                              *(LAS f32x4*)(As + (16 * w + qq) * AS + c0) = av; *(LAS f32x4*)(Us + (16 * w + qq) * AS + c0) = uv; } }
                        LBAR();
                        const int ch = tid & 63, sg = tid >> 6;
                        float pa[16], ph[16];
#pragma unroll
                        for (int t = 0; t < 16; ++t) { const int o = (16 * sg + t) * AS + ch; pa[t] = As[o]; ph[t] = Us[o]; }
                        { float P = 1.f, Hh = 0.f;
#pragma unroll
                          for (int t = 0; t < 16; ++t) { Hh = pa[t] * Hh + ph[t]; P *= pa[t]; pa[t] = P; ph[t] = Hh; }
                          sP[sg * 64 + ch] = P; sH[sg * 64 + ch] = Hh; }
                        LBAR();
                        { float c = cS[(tile & 1) * 64 + ch];
                          for (int s2 = 0; s2 < sg; ++s2) c = sP[s2 * 64 + ch] * c + sH[s2 * 64 + ch];
#pragma unroll
                          for (int t = 0; t < 16; ++t) Us[(16 * sg + t) * AS + ch] = ph[t] + pa[t] * c;
                          if (sg == 7) cS[((tile + 1) & 1) * 64 + ch] = sP[7 * 64 + ch] * c + sH[7 * 64 + ch]; }
                        LBAR();
#pragma unroll
                        for (int k = 0; k < 2; ++k) { const int idx = tid + 512 * k, t_ = idx >> 3, part = idx & 7;
                            const f32x4 h0 = *(const LAS f32x4*)(Us + t_ * AS + part * 8), h1 = *(const LAS f32x4*)(Us + t_ * AS + part * 8 + 4);
                            float gv[8]; unpack8(gcr[k], gv);
                            float o8[8];
#pragma unroll
                            for (int e = 0; e < 8; ++e) o8[e] = (e < 4 ? h0[e] : h1[e - 4]) * gelu_tanh(gv[e]);
                            *(v4u*)(HCG + (r0 + t_) * DM + chb + part * 8) = pack8(o8); }
                    }
                    __syncthreads();
                    if (tid < 64) out[O_PLRU + (size_t)(l * 16 + b) * DM + chb + tid] = cS[tid];
                }
                __syncthreads();
                for (int i = bx * 512 + tid; i < 32 * DM; i += G * 512) { const int sb = i >> 10, ch = i & 1023; const size_t r0 = (size_t)NPROMPT + sb * 8;
                    float hc = A->in[I_SLRU][(size_t)(l * 32 + sb) * DM + ch];
                    for (int t = 0; t < 8; ++t) { hc = AL[(size_t)(sb * 8 + t) * DM + ch] * hc + U[(size_t)(sb * 8 + t) * DM + ch]; HCG[(r0 + t) * DM + ch] = (bf16)f2bf(hc * gelu_tanh(bf2f(*ZP(Z, r0 + t, ZGC + ch)))); }
                    out[O_SLRU + (size_t)(l * 32 + sb) * DM + ch] = hc; }
            }
            if (SUB(pb + 5, 1))
            for (int row = gw; row < M; row += NGW) {
                const int hh = lane >> 3; const float l0 = LSE[((size_t)0 * M + row) * 8 + hh], l1 = LSE[((size_t)1 * M + row) * 8 + hh], l2 = LSE[((size_t)2 * M + row) * 8 + hh];
                const v4u r0 = *(const v4u*)(OG + ((size_t)0 * M + row) * 512 + 8 * lane), r1 = *(const v4u*)(OG + ((size_t)1 * M + row) * 512 + 8 * lane), r2 = *(const v4u*)(OG + ((size_t)2 * M + row) * 512 + 8 * lane);
                v4u yr[2], zr[2];
#pragma unroll
                for (int q = 0; q < 2; ++q) { const int col = q * 512 + 8 * lane; yr[q] = *(const v4u*)(YS + (size_t)row * DM + col); zr[q] = *(const v4u*)ZP(Z, row, ZZB + col); }
                { const float mx = fmaxf(l0, fmaxf(l1, l2)); const float e0 = __expf(l0 - mx), e1 = __expf(l1 - mx), e2 = __expf(l2 - mx); const float inv = rcpf_(e0 + e1 + e2);
                  float o0[8], o1[8], o2[8]; unpack8(r0, o0); unpack8(r1, o1); unpack8(r2, o2);
                  float o[8];
#pragma unroll
                  for (int e = 0; e < 8; ++e) o[e] = (e0 * o0[e] + e1 * o1[e] + e2 * o2[e]) * inv;
                  *(v4u*)(OA + (size_t)row * DM + 8 * lane) = pack8(o); }
#pragma unroll
                for (int q = 0; q < 2; ++q) { const int col = q * 512 + 8 * lane;
                    float yv[8]; unpack8(yr[q], yv);
                    float zz[8]; unpack8(zr[q], zz);
                    float v[8]; float ss = 0.f;
#pragma unroll
                    for (int e = 0; e < 8; ++e) { v[e] = yv[e] * siluf_(zz[e]); ss += v[e] * v[e]; }
                    const float rs = __builtin_amdgcn_rsqf(wave_sum(ss) * (1.f / 512.f) + EPS);
                    const float* gn = A->in[I_GSSM] + l * DM + col;
#pragma unroll
                    for (int e = 0; e < 8; ++e) v[e] = v[e] * rs * gn[e];
                    *(v4u*)(YN + (size_t)row * DM + col) = pack8(v); }
            }
        }
        SEAM(pb + 5);
        if (IN(pb + 6)) {
            PH_PTRS PH_LAYER
            sample_merge_units(lds, OA, YN, HCG, (const bf16*)(wl + WL_A), (const bf16*)(wl + WL_B), (const bf16*)(wl + WL_C), Z, MG, tid, vcu, G);
            pg8::Seg3Order<pg8::StaticOrder> S; S.b.init(NPROMPT, DM, G, bx);
            pg8::Gemm g{OA, (const bf16*)(wl + WL_A), M, DM, DM, DM, DM, 0, YN, (const bf16*)(wl + WL_B), HCG, (const bf16*)(wl + WL_C), 512};
            pg8::EpiMerge3 E{Z, ACC, MG};
            pg8::gemm_phase<pg8::EpiMerge3, pg8::Seg3Order<pg8::StaticOrder>, true>(lds, g, S, E);
        }
        SEAM(pb + 6);
        if (IN(pb + 7)) {
            PH_PTRS PH_LAYER
            sample_resid_units<DM>(lds, MG, DM, (const bf16*)(wl + WL_O), DM, X, modl + 5 * DM, PSCALE(pb + 7, 1.0f), XB, SSQ, GAM + (size_t)(l * 3 + 2) * NSEQ * DM, tid, vcu, G);
            pg8::Gemm g{MG, (const bf16*)(wl + WL_O), M, DM, DM, DM, DM, 0}; pg8::StaticOrder S; S.init(NPROMPT, DM, G, bx);
            pg8::EpiResid<true> E{X, modl + 5 * DM, PSCALE(pb + 7, 1.0f), XB, SSQ, GAM + (size_t)(l * 3 + 2) * NSEQ * DM};
            pg8::gemm_phase<pg8::EpiResid<true>, pg8::StaticOrder>(lds, g, S, E);
        }
        SEAM(pb + 7);
        if (IN(pb + 8)) {
            PH_PTRS PH_LAYER
            pg8::Gemm g{XB, (const bf16*)(wl + WL_F2I), M, 2 * DFF, DM, DM, DM, 0}; pg8::HalfOrder S; S.init(2 * DFF, G, bx);
            pg8::EpiSwiGLU E{Gb, SSQ, (const float*)(ws + WS_SHW3) + (size_t)l * NSEQ * 2 * DFF};
            pg8::gemm_phase<pg8::EpiSwiGLU, pg8::HalfOrder>(lds, g, S, E);
        }
        SEAM(pb + 8);
        if (IN(pb + 9)) {
            PH_PTRS PH_LAYER
            sample_resid_units<DFF>(lds, Gb, DFF, (const bf16*)(wl + WL_F2O), DFF, X, modl + 8 * DM, PSCALE(pb + 9, 0.5f), XB, SSQ, GAM + (size_t)((l < 1 ? l + 1 : l) * 3 + 0) * NSEQ * DM, tid, vcu, G);
            pg8::Gemm g{Gb, (const bf16*)(wl + WL_F2O), M, DM, DFF, DFF, DFF, 0}; pg8::StaticOrder S; S.init(NPROMPT, DM, G, bx);
            pg8::EpiResid<true> E{X, modl + 8 * DM, PSCALE(pb + 9, 0.5f), XB, SSQ, GAM + (size_t)((l < 1 ? l + 1 : l) * 3 + 0) * NSEQ * DM};
            pg8::gemm_phase<pg8::EpiResid<true>, pg8::StaticOrder>(lds, g, S, E);
        }
        SEAM(pb + 9);
    }
    if (IN(PH_FINAL)) {
        PH_PTRS
        const float* gvec = A->in[I_GFIN];
        f32x4 gv[4];
#pragma unroll
        for (int j = 0; j < 4; ++j) gv[j] = *(const f32x4*)(gvec + 4 * (lane + 64 * j));
        for (int row0 = gw; row0 < M; row0 += 4 * NGW) {
            v2u xw_[4][4];
#pragma unroll
            for (int k = 0; k < 4; ++k) { const int row = row0 + k * NGW;
#pragma unroll
                for (int j = 0; j < 4; ++j) { xw_[k][j] = (v2u){0u, 0u}; if (row < M) xw_[k][j] = *(const v2u*)(X + (size_t)row * DM + 4 * (lane + 64 * j)); } }
#pragma unroll
            for (int k = 0; k < 4; ++k) { const int row = row0 + k * NGW;
                if (row < M) {
                    float* o = out + (row < NPROMPT ? O_YP + (size_t)row * DM : O_YS + (size_t)(row - NPROMPT) * DM);
                    f32x4 v[4]; float ss = 0.f;
#pragma unroll
                    for (int j = 0; j < 4; ++j) { v[j] = (f32x4){bflo(xw_[k][j].x), bfhi(xw_[k][j].x), bflo(xw_[k][j].y), bfhi(xw_[k][j].y)}; ss += (v[j].x * v[j].x + v[j].y * v[j].y) + (v[j].z * v[j].z + v[j].w * v[j].w); }
                    const float rs = __builtin_amdgcn_rsqf(wave_sum(ss) * (1.f / DM) + EPS);
#pragma unroll
                    for (int j = 0; j < 4; ++j) { const int c = 4 * (lane + 64 * j); *(f32x4*)(o + c) = v[j] * rs * gv[j]; } } }
        }
    }
#undef IN
#undef SEAM
}

extern "C" void kernel_launch(void* const* d_in, const int* in_sizes, int n_in, void* d_out, int out_size, void* d_ws, size_t ws_size, hipStream_t stream) {
    static int grid = 0;
    if (grid == 0) {
        if (n_in != N_INPUTS || (size_t)out_size != O_END || ws_size < WS_END) { fprintf(stderr, "kernel_launch: unexpected shapes: n_in %d out %d ws %zu (need %zu)\n", n_in, out_size, ws_size, (size_t)WS_END); grid = -1; return; }
        int dev = 0, cus = 0;
        if (hipGetDevice(&dev) != hipSuccess || hipDeviceGetAttribute(&cus, hipDeviceAttributeMultiprocessorCount, dev) != hipSuccess) { grid = -1; return; }
        if (hipFuncSetAttribute((const void*)fwd, hipFuncAttributeMaxDynamicSharedMemorySize, LDS_BYTES) != hipSuccess) { fprintf(stderr, "kernel_launch: hipFuncSetAttribute failed\n"); grid = -1; return; }
        int per_cu = 0;
        if (hipOccupancyMaxActiveBlocksPerMultiprocessor(&per_cu, (const void*)fwd, NWAVES * 64, LDS_BYTES) != hipSuccess || per_cu < 1) fprintf(stderr, "kernel_launch: occupancy query reports %d\n", per_cu);
        (void)hipGetLastError();
        grid = cus;
    }
    if (grid < 0) return;
    if (hipMemsetAsync((char*)d_ws + WS_CTL, 0, CTL_ZERO_BYTES, stream) != hipSuccess) return;
    Args a{};
    for (int i = 0; i < N_INPUTS; ++i) a.in[i] = (const float*)d_in[i];
    a.out = (float*)d_out; a.ws = (unsigned char*)d_ws; a.li = 0; a.submask = 0xffffffffu; a.pad = 0;
#if defined(PROBE_A)
    a.ph_lo = 0; a.ph_hi = PROBE_B + 1; a.use_bar = 1; a.li = 0;
    hipLaunchKernelGGL(fwd, dim3(grid), dim3(NWAVES * 64), LDS_BYTES, stream, a);
    a.ph_lo = PROBE_A; a.ph_hi = NPHASES; a.use_bar = 1; a.li = 1; a.submask = PROBE_MASK;
    hipLaunchKernelGGL(fwd, dim3(grid), dim3(NWAVES * 64), LDS_BYTES, stream, a);
#elif ONE_LAUNCH
    a.ph_lo = 0; a.ph_hi = NPHASES; a.use_bar = 1;
    hipLaunchKernelGGL(fwd, dim3(grid), dim3(NWAVES * 64), LDS_BYTES, stream, a);
#else
    for (int ph = 0; ph < NPHASES; ++ph) {
        a.ph_lo = ph; a.ph_hi = ph + 1; a.use_bar = 0;
        hipLaunchKernelGGL(fwd, dim3(grid), dim3(NWAVES * 64), LDS_BYTES, stream, a);
    }
#endif
}
```

```cpp
#include <hip/hip_runtime.h>
#include <cstdio>
#include <cstdint>
#include <cmath>

#ifndef ONE_LAUNCH
#define ONE_LAUNCH 1
#endif

#define GAS __attribute__((address_space(1)))
#define LAS __attribute__((address_space(3)))
typedef unsigned short bf16;
typedef unsigned v4u __attribute__((ext_vector_type(4)));
typedef unsigned v2u __attribute__((ext_vector_type(2)));
typedef float f32x4 __attribute__((ext_vector_type(4)));
typedef short bf16x8 __attribute__((ext_vector_type(8)));
typedef short s16x4 __attribute__((ext_vector_type(4)));

constexpr int DM = 1024, NPROMPT = 16 * 2048, NSAMP = 256, M = NPROMPT + NSAMP, SEQ = 2048;
constexpr int DFF = 2816, NZ = 12288, NIN = 12304, NSEQ = 48, NMOD = 9216;
constexpr float EPS = 1e-6f;
constexpr int ZQ = 0, ZK = 1536, ZV = 3072, ZZB = 4608, ZXBC = 5632, ZXC = 7168, ZGC = 8192, ZGATE = 9216;

constexpr size_t MiB = 1u << 20;
constexpr size_t WS_CTL = 0, CTL_ZERO_BYTES = 1 * MiB;
constexpr size_t WS_WL = 1 * MiB, WL_STRIDE = 69 * MiB;
constexpr size_t WL_F1I = 0, WL_F1O = 11 * MiB, WL_IN = 17 * MiB  , WL_A = 67 * MiB  , WL_B = 43 * MiB, WL_C = 45 * MiB, WL_O = 47 * MiB,
                 WL_F2I = 49 * MiB, WL_F2O = 60 * MiB, WL_G = 66 * MiB;
constexpr int NZT = 12544;
constexpr size_t WS_WADA = WS_WL + 2 * WL_STRIDE;
constexpr size_t WS_SC = WS_WADA + 36 * MiB;
constexpr size_t WS_BIAS = WS_SC + 1 * MiB;
constexpr size_t WS_SPL = WS_BIAS + 512 * 1024;
constexpr size_t WS_MOD = WS_BIAS + 1 * MiB;
constexpr size_t WS_DT = WS_MOD + 4 * MiB;
constexpr size_t WS_LSE = WS_DT + 3 * MiB;
constexpr size_t WS_GAM = WS_LSE + 4 * MiB;
constexpr size_t WS_SHB = WS_GAM + 2 * MiB;
constexpr size_t WS_SHW1 = WS_SHB + 3 * MiB;
constexpr size_t WS_SHW2 = WS_SHW1 + 3 * MiB;
constexpr size_t WS_SHW3 = WS_SHW2 + 5 * MiB;
constexpr size_t WS_SSQ = WS_SHW3 + 3 * MiB;
constexpr size_t WS_X = WS_SSQ + 3 * MiB;
constexpr size_t WS_XB = WS_X + 129 * MiB;
constexpr size_t WS_MG = WS_XB + 65 * MiB;
constexpr size_t WS_Z = WS_MG + 65 * MiB;
constexpr size_t WS_XBCV = WS_Z + 774 * MiB;
constexpr size_t WS_XCV = WS_XBCV + 97 * MiB;
constexpr size_t WS_AL = WS_XCV + 65 * MiB;
constexpr size_t WS_U = WS_AL + 129 * MiB;
constexpr size_t WS_OG = WS_U + 129 * MiB;
constexpr size_t WS_YS = WS_OG + 97 * MiB;
constexpr size_t WS_OA = WS_YS + 129 * MiB;
constexpr size_t WS_HCG = WS_OA + 65 * MiB;
constexpr size_t WS_END = WS_HCG + 65 * MiB;

constexpr size_t O_YP = 0, O_YS = O_YP + 33554432, O_PKV1 = O_YS + 262144, O_PKV2 = O_PKV1 + 4194304, O_PKV3 = O_PKV2 + 16777216,
                 O_PCB = O_PKV3 + 67108864, O_PSSM = O_PCB + 147456, O_PCC = O_PSSM + 4194304, O_PLRU = O_PCC + 98304,
                 O_SKV1 = O_PLRU + 32768, O_SKV2 = O_SKV1 + 524288, O_SKV3 = O_SKV2 + 524288, O_SCB = O_SKV3 + 524288,
                 O_SSSM = O_SCB + 294912, O_SCC = O_SSSM + 8388608, O_SLRU = O_SCC + 196608, O_END = O_SLRU + 65536;

enum { I_XP = 0, I_XS, I_CP, I_CS, I_KV1, I_KV2, I_KV3, I_SCB, I_SSSM, I_SCC, I_SLRU, I_RELB, I_WADA, I_BADA, I_GFF1, I_WF1I, I_WF1O, I_GMIX, I_WIN,
       I_WA, I_CBW, I_CBB, I_DTB, I_ALOG, I_DSKIP, I_GSSM, I_WB, I_CCW, I_CCB, I_WR, I_BR, I_WI, I_BI, I_LAM, I_WC, I_WO, I_GFF2, I_WF2I, I_WF2O, I_GFIN, N_INPUTS };

__device__ __forceinline__ unsigned pk2(float lo, float hi) { unsigned r; asm("v_cvt_pk_bf16_f32 %0, %1, %2" : "=v"(r) : "v"(lo), "v"(hi)); return r; }
__device__ __forceinline__ unsigned f2bf(float f) { return pk2(f, 0.f) & 0xffffu; }
__device__ __forceinline__ float bflo(unsigned w) { return __builtin_bit_cast(float, w << 16); }
__device__ __forceinline__ float bfhi(unsigned w) { return __builtin_bit_cast(float, w & 0xffff0000u); }
__device__ __forceinline__ float bf2f(bf16 x) { return __builtin_bit_cast(float, (unsigned)x << 16); }
__device__ __forceinline__ void unpack8(const v4u w, float (&o)[8]) { o[0] = bflo(w.x); o[1] = bfhi(w.x); o[2] = bflo(w.y); o[3] = bfhi(w.y); o[4] = bflo(w.z); o[5] = bfhi(w.z); o[6] = bflo(w.w); o[7] = bfhi(w.w); }
__device__ __forceinline__ v4u pack8(const float (&o)[8]) { v4u w; w.x = pk2(o[0], o[1]); w.y = pk2(o[2], o[3]); w.z = pk2(o[4], o[5]); w.w = pk2(o[6], o[7]); return w; }
__device__ __forceinline__ float rcpf_(float x) { return __builtin_amdgcn_rcpf(x); }
__device__ __forceinline__ float sigmoidf_(float x) { return rcpf_(1.f + __expf(-x)); }
__device__ __forceinline__ float siluf_(float x) { return x * rcpf_(1.f + __expf(-x)); }
__device__ __forceinline__ float softplusf_(float x) { const float e = __expf(x); const float sm = e * (1.f - e * (0.5f - e * 0.33333334f)); return x > 20.f ? x : (e < 0.01f ? sm : __logf(1.f + e)); }
__device__ __forceinline__ float one_minus_exp(float y) { const float p = -y * (1.f + y * (0.5f + y * (0.16666667f + y * (0.041666668f + y * (0.0083333338f + y * 0.0013888889f))))); return y < -0.4f ? 1.f - __expf(y) : p; }
__device__ __forceinline__ float gelu_tanh(float x) { const float t = 0.7978845608028654f * (x + 0.044715f * x * x * x); return x * rcpf_(1.f + __expf(-2.f * t)); }
#define ZP(Zb, row, col) ((Zb) + ((size_t)((col) >> 8) * M + (size_t)(row)) * 256 + ((col) & 255))
__device__ __forceinline__ int seq_of_row(int row) { return row < NPROMPT ? (row >> 11) : 16 + ((row - NPROMPT) >> 3); }
__device__ __forceinline__ float wave_sum(float v) {
#pragma unroll
    for (int o = 1; o < 64; o <<= 1) v += __shfl_xor(v, o);
    return v;
}
__device__ __forceinline__ float wave_max(float v) {
#pragma unroll
    for (int o = 1; o < 64; o <<= 1) v = fmaxf(v, __shfl_xor(v, o));
    return v;
}
#define LDS_WAIT() asm volatile("s_waitcnt lgkmcnt(0)" ::: "memory")
#define LBAR() asm volatile("s_waitcnt lgkmcnt(0)\n\ts_barrier" ::: "memory")
__device__ __forceinline__ int lane_id() { return (int)__builtin_amdgcn_mbcnt_hi(~0u, __builtin_amdgcn_mbcnt_lo(~0u, 0u)); }
__device__ __forceinline__ v2u tr_read(const LAS bf16* tile, int stride, int r0, int c0, int qq) {
    typedef short v4i16_t __attribute__((ext_vector_type(4)));
    const LAS bf16* p = tile + (r0 + (qq >> 2)) * stride + c0 + 4 * (qq & 3);
    return __builtin_bit_cast(v2u, __builtin_amdgcn_ds_read_tr16_b64_v4i16((LAS v4i16_t*)p));
}

namespace pg8 {
#define PG8_LAS __attribute__((address_space(3)))
typedef unsigned short bf16_t;
typedef unsigned u32x4 __attribute__((ext_vector_type(4)));
constexpr int BM = 256, BK = 64, HALF = 128, HTB = HALF * BK * 2, STAGE_BYTES = 8 * HTB, NXCD = 8, WGM = 4;

__host__ __device__ __forceinline__ int lds_byte(int r, int c) { const int st = (r >> 4) * 2 + (c >> 5), rr = r & 15, cc = c & 31, ob = rr * 64 + cc * 2; return st * 1024 + (ob ^ (((ob >> 9) & 1) << 5)); }
__host__ __device__ __forceinline__ void stage_rc(int b, int& R, int& C) { const int st = b / 1024, sb = b % 1024, swz = sb ^ (((sb >> 9) & 1) << 5); R = (st >> 1) * 16 + swz / 64; C = (st & 1) * 32 + (swz % 64) / 2; }
__host__ __device__ __forceinline__ int perm32(int rho) { const int n = rho >> 4, i = rho & 15; return 8 * (i >> 2) + 4 * n + (i & 3); }

struct Unit { int pm, pn, half, seg; };
struct Gemm { const bf16_t* A; const bf16_t* Bt; int M, N, K, lda, ldb, a_pn_step; const bf16_t* A1; const bf16_t* Bt1; const bf16_t* A2; const bf16_t* Bt2; int K0; };

struct StaticOrder {
    int nM, nN, nwg, G, c;
    __host__ __device__ void init(int M_, int N_, int G_, int c_) { nM = M_ / BM; nN = N_ / BM; nwg = nM * nN; G = G_; c = c_; }
    __host__ __device__ bool next(int i, Unit& u) const {
        const long L = (long)i * G + c; if (L >= nwg) return false;
        int wgid = (int)L; { const int q = nwg / NXCD, r = nwg % NXCD, xcd = wgid % NXCD, off = wgid / NXCD; wgid = (xcd < r ? xcd * (q + 1) : r * (q + 1) + (xcd - r) * q) + off; }
        const int nig = WGM * nN, gid = wgid / nig, fm = gid * WGM, gsz = (nM - fm) < WGM ? (nM - fm) : WGM;
        u.pm = fm + ((wgid % nig) % gsz); u.pn = (wgid % nig) / gsz; u.half = -1; u.seg = 0; return true;
    }
};

__device__ __forceinline__ unsigned cvt_pk_bf16(float lo, float hi) { unsigned r; asm volatile("v_cvt_pk_bf16_f32 %0, %1, %2" : "=v"(r) : "v"(lo), "v"(hi)); return r; }

template <class Epi, class Sched, bool SEG3 = false>
__device__ __forceinline__ void gemm_phase(PG8_LAS unsigned char* lds, const Gemm g, const Sched& S, const Epi& E) {
    int tid_ = threadIdx.x; asm volatile("" : "+v"(tid_));
    const int tid = tid_, wid = __builtin_amdgcn_readfirstlane(tid >> 6), lane = tid & 63, wr = wid >> 2, wc = wid & 3, fr = lane & 15, fq = lane >> 4;
    int K_ = g.K; asm volatile("" : "+s"(K_)); const int K = K_, nt = K / BK;
    unsigned voffA[2], voffB[2];
#pragma unroll
    for (int i = 0; i < 2; ++i) { int R, C; stage_rc(tid * 16 + i * 8192, R, C); const int Rb = (R & ~31) + perm32(R & 31);
        voffA[i] = (unsigned)(R * g.lda + C) * 2u; voffB[i] = (unsigned)(Rb * g.ldb + C) * 2u; }
    const size_t kstep = (size_t)(BK * 2);
    const size_t hsA = (size_t)HALF * g.lda * 2, hsB = (size_t)HALF * g.ldb * 2;
    const size_t tsA = 2 * hsA, tsB = 2 * hsB;
    const unsigned ldsw = (unsigned)wid * 1024u;
    const int aoff = lds_byte(wr * 64 + fr, fq * 8), boff = lds_byte(wc * 32 + fr, fq * 8);
#define PG8_SA(b, h) (((b) * 2 + (h)) * HTB)
#define PG8_SB(b, h) ((4 + (b) * 2 + (h)) * HTB)
#define PG8_STAGE(bufoff, gbase, voff) do { _Pragma("unroll") for (int _i = 0; _i < 2; ++_i) \
        __builtin_amdgcn_global_load_lds((const unsigned*)((const char*)(gbase) + (voff)[_i]), (PG8_LAS unsigned*)(lds + (bufoff) + ldsw + _i * 8192), 16, 0, 0); } while (0)
#define PG8_LDA(dst, b, h) do { _Pragma("unroll") for (int m = 0; m < 4; ++m) _Pragma("unroll") for (int k = 0; k < 2; ++k) dst[m][k] = *(const PG8_LAS bf16x8*)(lds + PG8_SA(b, h) + aoff + m * 2048 + k * 1024); } while (0)
#define PG8_LDB(dst, b, h) do { _Pragma("unroll") for (int n = 0; n < 2; ++n) _Pragma("unroll") for (int k = 0; k < 2; ++k) dst[n][k] = *(const PG8_LAS bf16x8*)(lds + PG8_SB(b, h) + boff + n * 2048 + k * 1024); } while (0)
#define PG8_MMA(ai, bj, At, Bt) do { __builtin_amdgcn_s_setprio(1); _Pragma("unroll") for (int m = 0; m < 4; ++m) _Pragma("unroll") for (int n = 0; n < 2; ++n) _Pragma("unroll") for (int k = 0; k < 2; ++k) \
        acc[ai][bj][m][n] = __builtin_amdgcn_mfma_f32_16x16x32_bf16(Bt[n][k], At[m][k], acc[ai][bj][m][n], 0, 0, 0); __builtin_amdgcn_s_setprio(0); } while (0)
#define PG8_WAIT_V(n) asm volatile("s_waitcnt vmcnt(" #n ")" ::: "memory")
#define PG8_WAIT_L(n) do { asm volatile("s_waitcnt lgkmcnt(" #n ")" ::: "memory"); __builtin_amdgcn_s_waitcnt(0xC07F); } while (0)
#define PG8_BAR __builtin_amdgcn_s_barrier()
#define PG8_SCHED __builtin_amdgcn_sched_barrier(0)
    Unit cur, nxt; int ui = 0;
    if (!S.next(0, cur)) return;
    f32x4 acc[2][2][4][2];
    { float zr_ = 0.f; asm volatile("" : "+v"(zr_));
#pragma unroll
    for (int a = 0; a < 2; ++a)
#pragma unroll
        for (int b = 0; b < 2; ++b)
#pragma unroll
            for (int m = 0; m < 4; ++m)
#pragma unroll
                for (int n = 0; n < 2; ++n) acc[a][b][m][n] = (f32x4){zr_, zr_, zr_, zr_}; }
#define PG8_UA(u_) ((const char*)(SEG3 ? ((u_).seg == 0 ? g.A : ((u_).seg == 1 ? g.A1 : g.A2)) : g.A) + (size_t)(u_).pm * tsA + (size_t)(u_).pn * g.a_pn_step * 2)
#define PG8_UB(u_) ((const char*)(SEG3 ? ((u_).seg == 0 ? g.Bt : ((u_).seg == 1 ? g.Bt1 : g.Bt2)) : g.Bt) + (size_t)(u_).pn * tsB)
#define PG8_UNT(u_) ((SEG3 && (u_).seg == 0) ? g.K0 / BK : nt)
    const char* cA = PG8_UA(cur); const char* cB = PG8_UB(cur); int ntc = PG8_UNT(cur);
    PG8_STAGE(PG8_SB(0, 0), cB, voffB); PG8_STAGE(PG8_SB(0, 1), cB + hsB, voffB); PG8_STAGE(PG8_SA(0, 0), cA, voffA); PG8_STAGE(PG8_SA(0, 1), cA + hsA, voffA);
    if (wr == 1) PG8_BAR;
    PG8_WAIT_V(2); PG8_BAR;
    PG8_STAGE(PG8_SB(1, 0), cB + kstep, voffB); PG8_STAGE(PG8_SA(1, 0), cA + kstep, voffA); PG8_STAGE(PG8_SB(1, 1), cB + hsB + kstep, voffB);
    PG8_WAIT_V(6); PG8_BAR;
    for (;;) {
        const bool has_next = S.next(ui + 1, nxt);
        const char* nA = has_next ? PG8_UA(nxt) : cA; const char* nB = has_next ? PG8_UB(nxt) : cB; const int ntn = has_next ? PG8_UNT(nxt) : ntc;
        __builtin_amdgcn_s_waitcnt(0xC07F);
        for (int t = 0; t < ntc; t += 2) {
            bf16x8 At[4][2], B0[2][2], B1[2][2];
            const bool last = (t == ntc - 2);
            const char* a1 = cA + (size_t)(t + 1) * kstep;
            const char* a2 = last ? nA : cA + (size_t)(t + 2) * kstep; const char* b2 = last ? nB : cB + (size_t)(t + 2) * kstep;
            const char* a3 = a2 + kstep; const char* b3 = b2 + kstep;
            PG8_LDB(B0, 0, 0); PG8_LDB(B1, 0, 1); PG8_SCHED; PG8_LDA(At, 0, 0); PG8_STAGE(PG8_SA(1, 1), a1 + hsA, voffA);
            PG8_WAIT_V(8); PG8_WAIT_L(0); PG8_BAR; if (cur.half != 1) { PG8_MMA(0, 0, At, B0); PG8_MMA(0, 1, At, B1); } PG8_BAR; PG8_SCHED;
            PG8_LDA(At, 0, 1); PG8_STAGE(PG8_SB(0, 0), b2, voffB); PG8_STAGE(PG8_SB(0, 1), b2 + hsB, voffB); PG8_STAGE(PG8_SA(0, 0), a2, voffA);
            PG8_WAIT_V(8); PG8_WAIT_L(0); PG8_BAR; if (cur.half != 0) { PG8_MMA(1, 0, At, B0); PG8_MMA(1, 1, At, B1); } PG8_BAR; PG8_SCHED;
            PG8_LDB(B0, 1, 0); PG8_LDB(B1, 1, 1); PG8_SCHED; PG8_LDA(At, 1, 0); PG8_STAGE(PG8_SA(0, 1), a2 + hsA, voffA);
            PG8_WAIT_V(8); PG8_WAIT_L(0); PG8_BAR; if (cur.half != 1) { PG8_MMA(0, 0, At, B0); PG8_MMA(0, 1, At, B1); } PG8_BAR; PG8_SCHED;
            PG8_LDA(At, 1, 1); PG8_STAGE(PG8_SB(1, 0), b3, voffB); PG8_STAGE(PG8_SB(1, 1), b3 + hsB, voffB); PG8_STAGE(PG8_SA(1, 0), a3, voffA);
            PG8_WAIT_V(8); PG8_WAIT_L(0); PG8_BAR; if (cur.half != 0) { PG8_MMA(1, 0, At, B0); PG8_MMA(1, 1, At, B1); } PG8_BAR; PG8_SCHED;
        }
        if (wr == 0) PG8_BAR;
        E(acc, cur, wr, wc, fr, fq);
        if (!has_next) break;
        { float zr_ = 0.f; asm volatile("" : "+v"(zr_));
#pragma unroll
        for (int a = 0; a < 2; ++a)
#pragma unroll
            for (int b = 0; b < 2; ++b)
#pragma unroll
                for (int m = 0; m < 4; ++m)
#pragma unroll
                    for (int n = 0; n < 2; ++n) acc[a][b][m][n] = (f32x4){zr_, zr_, zr_, zr_}; }
        cur = nxt; cA = nA; cB = nB; ntc = ntn; ++ui;
        if (wr == 1) PG8_BAR;
    }
    PG8_WAIT_V(0);
    PG8_BAR;
#undef PG8_UA
#undef PG8_UB
#undef PG8_UNT
#undef PG8_SA
#undef PG8_SB
#undef PG8_STAGE
#undef PG8_LDA
#undef PG8_LDB
#undef PG8_MMA
#undef PG8_WAIT_V
#undef PG8_WAIT_L
#undef PG8_BAR
#undef PG8_SCHED
}

struct HalfOrder {
    StaticOrder mn; int nN, G, c;
    __host__ __device__ void init(int N_, int G_, int c_) { nN = N_ / BM; mn.init(NPROMPT, N_, G_, c_); G = G_; c = c_; }
    __host__ __device__ bool next(int i, Unit& u) const {
        const long L = (long)i * G + c;
        if (L < mn.nwg) return mn.next(i, u);
        const int j = (int)(L - mn.nwg); if (j >= 2 * nN) return false;
        u.pm = NPROMPT / BM; u.pn = j % nN; u.half = j / nN; u.seg = 0; return true;
    }
};
template <class Base> struct Seg3Order {
    Base b;
    __host__ __device__ bool next(int i, Unit& u) const { const int q = i / 3; if (!b.next(q, u)) return false; u.seg = i - 3 * q; return true; }
};
struct SampleOrder {
    int nN, G, c;
    __host__ __device__ void init(int nN_, int G_, int c_) { nN = nN_; G = G_; c = c_; }
    __host__ __device__ bool next(int i, Unit& u) const { const long L = (long)i * G + c; if (L >= nN) return false; u.pm = NPROMPT / BM; u.pn = (int)L; u.half = -1; u.seg = 0; return true; }
};
#define EPI_ROWS_BEGIN _Pragma("unroll") for (int ai = 0; ai < 2; ++ai) if (ai == 0 ? u.half != 1 : u.half != 0) _Pragma("unroll") for (int m = 0; m < 4; ++m) {     const int row = u.pm * BM + ai * HALF + wr * 64 + m * 16 + fr;
#define EPI_ROWS_END }
typedef const f32x4 (&AccT)[2][2][4][2];

__device__ __forceinline__ float row_rs(const float* SSQ, int row, int fq) {
    const f32x4 a = *(const f32x4*)(SSQ + (size_t)row * 16 + 4 * fq);
    float t = (a.x + a.y) + (a.z + a.w);
    t += __shfl_xor(t, 16); t += __shfl_xor(t, 32);
    return __builtin_amdgcn_rsqf(t * (1.f / DM) + EPS);
}
struct EpiMod {
    float* MOD; const float* bada; bf16_t* SHB;
    __device__ __forceinline__ void operator()(AccT acc, const Unit& u, int wr, int wc, int fr, int fq) const {
        const int col0 = u.pn * BM + wc * 32 + 8 * fq;
        EPI_ROWS_BEGIN
            if (row < NSEQ) {
#pragma unroll
                for (int bj = 0; bj < 2; ++bj) { const int c = col0 + bj * HALF; const int l = c / NMOD, j = c - l * NMOD, chunk = j >> 10, cj = j & 1023, k = chunk / 3, kind = chunk - 3 * k;
                    float* o = MOD + ((size_t)(l * NSEQ + row)) * NMOD + j; const float* b = bada + c;
                    const f32x4 v0 = acc[ai][bj][m][0] + *(const f32x4*)b, v1 = acc[ai][bj][m][1] + *(const f32x4*)(b + 4);
                    *(f32x4*)o = v0; *(f32x4*)(o + 4) = v1;
                    if (kind == 0) { u32x4 w; w.x = cvt_pk_bf16(v0[0], v0[1]); w.y = cvt_pk_bf16(v0[2], v0[3]); w.z = cvt_pk_bf16(v1[0], v1[1]); w.w = cvt_pk_bf16(v1[2], v1[3]);
                        *(u32x4*)(SHB + ((size_t)(l * 3 + k) * 256 + row) * DM + cj) = w; }
 }
            }
        EPI_ROWS_END
    }
};
struct EpiShw {
    float* O; int N;
    __device__ __forceinline__ void operator()(AccT acc, const Unit& u, int wr, int wc, int fr, int fq) const {
        const int col0 = u.pn * BM + wc * 32 + 8 * fq;
        EPI_ROWS_BEGIN
            if (row < NSEQ) {
#pragma unroll
                for (int bj = 0; bj < 2; ++bj) { float* o = O + (size_t)row * N + col0 + bj * HALF; *(f32x4*)o = acc[ai][bj][m][0]; *(f32x4*)(o + 4) = acc[ai][bj][m][1]; } }
        EPI_ROWS_END
    }
};
struct EpiSwiGLU {
    bf16_t* Gb; const float* SSQ; const float* SHW;
    __device__ __forceinline__ void operator()(AccT acc, const Unit& u, int wr, int wc, int fr, int fq) const {
        const int col0 = u.pn * HALF + wc * 32 + 8 * fq, tc0 = u.pn * BM + wc * 32 + 8 * fq;
        const bool uni = u.pm < NPROMPT / BM;
        f32x4 su[2] = {(f32x4){0.f, 0.f, 0.f, 0.f}, (f32x4){0.f, 0.f, 0.f, 0.f}}, sv[2] = {(f32x4){0.f, 0.f, 0.f, 0.f}, (f32x4){0.f, 0.f, 0.f, 0.f}};
        if (uni) { const float* sw = SHW + (size_t)(u.pm >> 3) * (2 * DFF) + tc0; su[0] = *(const f32x4*)sw; su[1] = *(const f32x4*)(sw + 4); sv[0] = *(const f32x4*)(sw + HALF); sv[1] = *(const f32x4*)(sw + HALF + 4); }
        float rs8[8];
#pragma unroll
        for (int r8 = 0; r8 < 8; ++r8) rs8[r8] = row_rs(SSQ, u.pm * BM + (r8 >> 2) * HALF + wr * 64 + (r8 & 3) * 16 + fr, fq);
        EPI_ROWS_BEGIN
            const float rs = rs8[ai * 4 + m];
            if (!uni) { const float* sw = SHW + (size_t)seq_of_row(row) * (2 * DFF) + tc0; su[0] = *(const f32x4*)sw; su[1] = *(const f32x4*)(sw + 4); sv[0] = *(const f32x4*)(sw + HALF); sv[1] = *(const f32x4*)(sw + HALF + 4); }
            float o[8];
#pragma unroll
            for (int n = 0; n < 2; ++n)
#pragma unroll
                for (int e = 0; e < 4; ++e) { const float uu = rs * acc[ai][0][m][n][e] + su[n][e], vv = rs * acc[ai][1][m][n][e] + sv[n][e]; o[4 * n + e] = siluf_(uu) * vv; }
            u32x4 w; w.x = cvt_pk_bf16(o[0], o[1]); w.y = cvt_pk_bf16(o[2], o[3]); w.z = cvt_pk_bf16(o[4], o[5]); w.w = cvt_pk_bf16(o[6], o[7]);
            *(u32x4*)(Gb + (size_t)row * DFF + col0) = w;
        EPI_ROWS_END
    }
};
template <bool NEXT> struct EpiResid {
    bf16_t* X; const float* gate; float scale;
    bf16_t* XB; float* SSQ; const float* gam;
    template <int AI> __device__ __forceinline__ void half_rows(AccT acc, int row0, int col0, int slot, int sq, int fq, const f32x4 (&gsc)[4]) const {
        v4u xw[4][2];
#pragma unroll
        for (int m = 0; m < 4; ++m)
#pragma unroll
            for (int bj = 0; bj < 2; ++bj) xw[m][bj] = *(const v4u*)(X + (size_t)(row0 + m * 16) * DM + col0 + bj * HALF);
#pragma unroll
        for (int m = 0; m < 4; ++m) { const int row = row0 + m * 16;
            float ss = 0.f;
#pragma unroll
            for (int bj = 0; bj < 2; ++bj) { const size_t off = (size_t)row * DM + col0 + bj * HALF;
                float xi[8]; unpack8(xw[m][bj], xi);
                const f32x4 x0 = (f32x4){xi[0], xi[1], xi[2], xi[3]} + gsc[bj * 2] * acc[AI][bj][m][0], x1 = (f32x4){xi[4], xi[5], xi[6], xi[7]} + gsc[bj * 2 + 1] * acc[AI][bj][m][1];
                { u32x4 xs_; xs_.x = cvt_pk_bf16(x0[0], x0[1]); xs_.y = cvt_pk_bf16(x0[2], x0[3]); xs_.z = cvt_pk_bf16(x1[0], x1[1]); xs_.w = cvt_pk_bf16(x1[2], x1[3]); *(u32x4*)(X + off) = xs_; }
                if (NEXT) { ss += ((x0.x * x0.x + x0.y * x0.y) + (x0.z * x0.z + x0.w * x0.w)) + ((x1.x * x1.x + x1.y * x1.y) + (x1.z * x1.z + x1.w * x1.w));
                    const float* gp_ = gam + (size_t)sq * DM + col0 + bj * HALF; const f32x4 y0 = x0 * *(const f32x4*)gp_, y1 = x1 * *(const f32x4*)(gp_ + 4);
                    u32x4 w; w.x = cvt_pk_bf16(y0[0], y0[1]); w.y = cvt_pk_bf16(y0[2], y0[3]); w.z = cvt_pk_bf16(y1[0], y1[1]); w.w = cvt_pk_bf16(y1[2], y1[3]);
                    *(u32x4*)(XB + off) = w; } }
            if (NEXT) { ss += __shfl_xor(ss, 16); ss += __shfl_xor(ss, 32); if (fq == 0) SSQ[(size_t)row * 16 + slot] = ss; } }
    }
    __device__ __forceinline__ void operator()(AccT acc, const Unit& u, int wr, int wc, int fr, int fq) const {
        const int upm = u.pm, upn = u.pn, uhalf = u.half;
        const int col0 = upn * BM + wc * 32 + 8 * fq, sq = upm >> 3, slot = upn * 4 + wc, rbase = upm * BM + wr * 64 + fr;
        f32x4 gsc[4];
#pragma unroll
        for (int q = 0; q < 4; ++q) gsc[q] = *(const f32x4*)(gate + (size_t)sq * NMOD + col0 + (q >> 1) * HALF + 4 * (q & 1)) * scale;
        if (uhalf != 1) half_rows<0>(acc, rbase, col0, slot, sq, fq, gsc);
        if (uhalf != 0) half_rows<1>(acc, rbase + HALF, col0, slot, sq, fq, gsc);
    }
};
struct EpiZ {
    bf16_t* Z; const float* SSQ; const float* SHW; float* out; float* DT; const float* dtb; int l;
    __device__ __forceinline__ void operator()(AccT acc, const Unit& u, int wr, int wc, int fr, int fq) const {
        const int col0 = u.pn * BM + wc * 32 + 8 * fq;
        const bool uni = u.pm < NPROMPT / BM;
        f32x4 sh[2][2] = {{(f32x4){0.f, 0.f, 0.f, 0.f}, (f32x4){0.f, 0.f, 0.f, 0.f}}, {(f32x4){0.f, 0.f, 0.f, 0.f}, (f32x4){0.f, 0.f, 0.f, 0.f}}};
        if (uni) { const float* sw = SHW + (size_t)(u.pm >> 3) * NZT + col0;
#pragma unroll
            for (int bj = 0; bj < 2; ++bj) { sh[bj][0] = *(const f32x4*)(sw + bj * HALF); sh[bj][1] = *(const f32x4*)(sw + bj * HALF + 4); } }
        float rs8[8];
#pragma unroll
        for (int r8 = 0; r8 < 8; ++r8) rs8[r8] = row_rs(SSQ, u.pm * BM + (r8 >> 2) * HALF + wr * 64 + (r8 & 3) * 16 + fr, fq);
        const int side = (u.pn >= 6 && u.pn < 18) ? 1 : ((u.pn >= 22 && u.pn < 32) ? 2 : 0);
        EPI_ROWS_BEGIN
            const float rs = rs8[ai * 4 + m];
            const int sq = seq_of_row(row); const bool isS = row >= NPROMPT; const int t = isS ? ((row - NPROMPT) & 7) : (row & (SEQ - 1));
            if (!uni) { const float* sw = SHW + (size_t)sq * NZT + col0;
#pragma unroll
                for (int bj = 0; bj < 2; ++bj) { sh[bj][0] = *(const f32x4*)(sw + bj * HALF); sh[bj][1] = *(const f32x4*)(sw + bj * HALF + 4); }
                asm volatile("" :: "v"(sh[0][0]), "v"(sh[0][1]), "v"(sh[1][0]), "v"(sh[1][1])); }
#pragma unroll
            for (int bj = 0; bj < 2; ++bj) { const int c = col0 + bj * HALF;
                const f32x4 v0 = acc[ai][bj][m][0] * rs + sh[bj][0], v1 = acc[ai][bj][m][1] * rs + sh[bj][1];
                if (u.pn < 48) {
                    u32x4 w; w.x = cvt_pk_bf16(v0[0], v0[1]); w.y = cvt_pk_bf16(v0[2], v0[3]); w.z = cvt_pk_bf16(v1[0], v1[1]); w.w = cvt_pk_bf16(v1[2], v1[3]);
                    *(u32x4*)ZP(Z, row, c) = w;
                    if (side) {
                        float* dst = nullptr;
                        if (side == 1) {
                            const int kv = c >= ZV ? 1 : 0, cc = c - (kv ? ZV : ZK), g = cc >> 9, ci = cc & 511; const int keep = g == 0 ? 128 : (g == 1 ? 512 : 2048);
                            if (isS) dst = out + (g == 0 ? O_SKV1 : (g == 1 ? O_SKV2 : O_SKV3)) + ((size_t)(l * 32 + (sq - 16)) * 8 + t) * 1024 + kv * 512 + ci;
                            else if (t >= SEQ - keep) dst = out + (g == 0 ? O_PKV1 : (g == 1 ? O_PKV2 : O_PKV3)) + ((size_t)(l * 16 + sq) * keep + (t - (SEQ - keep))) * 1024 + kv * 512 + ci;
                        } else {
                            const int tl = isS ? 8 : SEQ;
                            if (t >= tl - 3) { const int i3 = t - (tl - 3);
                                if (c < ZXC) dst = out + (isS ? O_SCB + ((size_t)(l * 32 + (sq - 16)) * 3 + i3) * 1536 : O_PCB + ((size_t)(l * 16 + sq) * 3 + i3) * 1536) + (c - ZXBC);
                                else dst = out + (isS ? O_SCC + ((size_t)(l * 32 + (sq - 16)) * 3 + i3) * 1024 : O_PCC + ((size_t)(l * 16 + sq) * 3 + i3) * 1024) + (c - ZXC); }
                        }
                        if (dst) { *(f32x4*)dst = v0; *(f32x4*)(dst + 4) = v1; }
                    }
                } else if (bj == 0 && wc == 0 && fq < 2) {
                    float* d = DT + (size_t)row * 16 + 8 * fq; const float* bb = dtb + 8 * fq;
                    *(f32x4*)d = (f32x4){softplusf_(v0[0] + bb[0]), softplusf_(v0[1] + bb[1]), softplusf_(v0[2] + bb[2]), softplusf_(v0[3] + bb[3])};
                    *(f32x4*)(d + 4) = (f32x4){softplusf_(v1[0] + bb[4]), softplusf_(v1[1] + bb[5]), softplusf_(v1[2] + bb[6]), softplusf_(v1[3] + bb[7])};
                }
            }
        EPI_ROWS_END
    }
};
struct EpiLru {
    const bf16_t* XCV; const float* br; const float* bi; const float* lam; float* AL; float* U;
    __device__ __forceinline__ void operator()(AccT acc, const Unit& u, int wr, int wc, int fr, int fq) const {
        const int ch0 = u.pn * HALF + wc * 32 + 8 * fq;
        EPI_ROWS_BEGIN
#pragma unroll
            for (int n = 0; n < 2; ++n) { const int ch = ch0 + 4 * n;
                const f32x4 brv = *(const f32x4*)(br + ch), biv = *(const f32x4*)(bi + ch), sp = *(const f32x4*)(lam + ch);
                const v2u xw = *(const v2u*)(XCV + (size_t)row * DM + ch); const float xv[4] = {bflo(xw.x), bfhi(xw.x), bflo(xw.y), bfhi(xw.y)};
                f32x4 av, uv;
#pragma unroll
                for (int e = 0; e < 4; ++e) {
                    const float rg = sigmoidf_(acc[ai][0][m][n][e] + brv[e]), ig = sigmoidf_(acc[ai][1][m][n][e] + biv[e]);
                    const float la = sp[e] * rg; av[e] = __expf(la); uv[e] = xv[e] * ig * __builtin_amdgcn_sqrtf(one_minus_exp(2.f * la)); }
                *(f32x4*)(AL + (size_t)row * DM + ch) = av; *(f32x4*)(U + (size_t)row * DM + ch) = uv; }
        EPI_ROWS_END
    }
};
struct EpiMerge3 {
    const bf16_t* Zg;
    bf16_t* ACC; bf16_t* MG;
    template <int AI> __device__ __forceinline__ void half_rows(AccT acc, int row0, int col0, int seg) const {
        v4u gw[4][2], pw[4][2];
#pragma unroll
        for (int m = 0; m < 4; ++m)
#pragma unroll
            for (int bj = 0; bj < 2; ++bj) { gw[m][bj] = *(const v4u*)ZP(Zg, row0 + m * 16, ZGATE + seg * DM + col0 + bj * HALF);
                pw[m][bj] = (v4u){0u, 0u, 0u, 0u}; if (seg > 0) pw[m][bj] = *(const v4u*)(ACC + (size_t)(row0 + m * 16) * DM + col0 + bj * HALF); }
#pragma unroll
        for (int m = 0; m < 4; ++m)
#pragma unroll
            for (int bj = 0; bj < 2; ++bj) { const size_t off = (size_t)(row0 + m * 16) * DM + col0 + bj * HALF;
                float gv[8], pv[8], o[8]; unpack8(gw[m][bj], gv); unpack8(pw[m][bj], pv);
#pragma unroll
                for (int n = 0; n < 2; ++n)
#pragma unroll
                    for (int e = 0; e < 4; ++e) o[4 * n + e] = pv[4 * n + e] + sigmoidf_(gv[4 * n + e]) * acc[AI][bj][m][n][e];
                u32x4 w; w.x = cvt_pk_bf16(o[0], o[1]); w.y = cvt_pk_bf16(o[2], o[3]); w.z = cvt_pk_bf16(o[4], o[5]); w.w = cvt_pk_bf16(o[6], o[7]);
                if (seg < 2) *(u32x4*)(ACC + off) = w; else *(u32x4*)(MG + off) = w; }
    }
    __device__ __forceinline__ void operator()(AccT acc, const Unit& u, int wr, int wc, int fr, int fq) const {
        const int upm = u.pm, upn = u.pn, uhalf = u.half, seg = u.seg;
        const int col0 = upn * BM + wc * 32 + 8 * fq, rbase = upm * BM + wr * 64 + fr;
        if (uhalf != 1) half_rows<0>(acc, rbase, col0, seg);
        if (uhalf != 0) half_rows<1>(acc, rbase + HALF, col0, seg);
    }
};
}

#define XB_TMO      128
#define XB_XCNT(j)  (256  + 64 * (j))
#define XB_XSUB(j)  (1280 + 64 * (j))
#define XB_XGEN(j)  (2304 + 64 * (j))
#define XB_TOP      3328
#define XB_TOPGEN   3392
#define XCD_BAR_WORDS 3456
#define XB_SPIN_CAP (1u << 18)
__device__ __forceinline__ unsigned xb_ld(unsigned* p)              { return __hip_atomic_load(p, __ATOMIC_RELAXED, __HIP_MEMORY_SCOPE_AGENT); }
__device__ __forceinline__ unsigned xb_add(unsigned* p, unsigned v) { return __hip_atomic_fetch_add(p, v, __ATOMIC_RELAXED, __HIP_MEMORY_SCOPE_AGENT); }
__device__ __forceinline__ unsigned xb_xcc_id() { return (unsigned)__builtin_amdgcn_s_getreg((3 << 11) | 20) & 0xFu; }
#define XB_SPIN(cond, bar) do { unsigned _sp = 0; while (cond) { __builtin_amdgcn_s_sleep(1); \
    if ((++_sp & 255u) == 0u) { if (xb_ld(&(bar)[XB_TMO])) break; if (_sp > XB_SPIN_CAP) { atomicAdd(&(bar)[XB_TMO], 1u); break; } } } } while (0)
struct XcdBarrier { unsigned* bar; unsigned x; volatile LAS unsigned* st; };
__device__ __forceinline__ XcdBarrier xcd_barrier_post(unsigned* bar, volatile LAS unsigned* st, int tid) {
    XcdBarrier b; b.bar = bar; b.x = xb_xcc_id(); b.st = st;
    if (tid == 0) (void)xb_add(&bar[XB_XCNT(b.x)], 1u);
    return b;
}
__device__ __forceinline__ void xcd_barrier_complete(unsigned* bar, unsigned x, unsigned& nloc, unsigned& nx) {
    const unsigned G = gridDim.x * gridDim.y * gridDim.z;
    unsigned sum, cnt, mine, sp = 0u;
    for (;;) {
        sum = 0u; cnt = 0u; mine = 0u;
#pragma unroll
        for (unsigned j = 0; j < 16; ++j) { const unsigned c = xb_ld(&bar[XB_XCNT(j)]); sum += c; cnt += (c > 0u) ? 1u : 0u; mine = (j == x) ? c : mine; }
        if (sum == G) break;
        __builtin_amdgcn_s_sleep(1);
        if ((++sp & 255u) == 0u) { if (xb_ld(&bar[XB_TMO])) break; if (sp > XB_SPIN_CAP) { atomicAdd(&bar[XB_TMO], 1u); break; } }
    }
    nloc = mine > 0u ? mine : 1u; nx = cnt > 0u ? cnt : 1u;
}
__device__ __forceinline__ void xcd_barrier(const XcdBarrier& b, int tid) {
    asm volatile("s_waitcnt vmcnt(0)" ::: "memory");
    __syncthreads();
    if (tid == 0) {
        unsigned* bar = b.bar;
        __builtin_amdgcn_s_waitcnt(0);
        unsigned nloc = b.st[0], nx = b.st[1];
        if (nloc == 0u) { xcd_barrier_complete(bar, b.x, nloc, nx); b.st[0] = nloc; b.st[1] = nx; }
        const unsigned old = xb_add(&bar[XB_XSUB(b.x)], 1u);
        const unsigned gen = old / nloc;
        if (old + 1u == (gen + 1u) * nloc) {
            __builtin_amdgcn_fence(__ATOMIC_RELEASE, "agent");
            asm volatile("s_waitcnt vmcnt(0)" ::: "memory");
            const unsigned og = xb_add(&bar[XB_TOP], 1u);
            const unsigned tg = og / nx;
            if (og + 1u == (tg + 1u) * nx) xb_add(&bar[XB_TOPGEN], 1u);
            else XB_SPIN(xb_ld(&bar[XB_TOPGEN]) == tg, bar);
            __builtin_amdgcn_fence(__ATOMIC_ACQUIRE, "agent");
            xb_add(&bar[XB_XGEN(b.x)], 1u);
            asm volatile("s_waitcnt vmcnt(0)" ::: "memory");
        } else {
            XB_SPIN(xb_ld(&bar[XB_XGEN(b.x)]) == gen, bar);
            __builtin_amdgcn_fence(__ATOMIC_ACQUIRE, "agent");
            asm volatile("s_waitcnt vmcnt(0)" ::: "memory");
        }
    }
    __syncthreads();
}

constexpr int NWAVES = 8;
constexpr int LDS_BYTES = 147456, LDSCTL_OFF = LDS_BYTES - 512, MISC_OFF = LDSCTL_OFF + 320;
constexpr int CW_BAR = 4096;
constexpr int NPH_LAYER = 10, PH_L0 = 3, PH_FINAL = PH_L0 + 2 * NPH_LAYER, NPHASES = PH_FINAL + 1;

struct Args { const float* in[N_INPUTS]; float* out; unsigned char* ws; int ph_lo, ph_hi, use_bar, li; unsigned submask; int pad; };
typedef const __attribute__((address_space(4))) Args* KArgs;
__device__ __forceinline__ KArgs kargs() { KArgs p = (KArgs)__builtin_amdgcn_kernarg_segment_ptr(); asm volatile("" : "+s"(p)); return p; }
#define PH_PTRS KArgs A = kargs(); unsigned char* ws = A->ws; float* out = A->out; (void)out; \
    LAS unsigned char* lds = lds0; asm volatile("" : "+s"(lds));   \
    int G = G0, bx = bx0, vcu = vcu0; asm volatile("" : "+s"(G), "+s"(bx), "+s"(vcu)); const int NGW = G * NWAVES; (void)NGW;   \
    int tid = threadIdx.x; asm volatile("" : "+v"(tid)); const int lane = tid & 63, wave = __builtin_amdgcn_readfirstlane(tid >> 6), gw = vcu * NWAVES + wave; (void)lane; (void)wave; (void)gw; \
    bf16* SC = (bf16*)(ws + WS_SC); float* BIASG = (float*)(ws + WS_BIAS); float* MOD = (float*)(ws + WS_MOD); float* DT = (float*)(ws + WS_DT); \
    float* LSE = (float*)(ws + WS_LSE); bf16* X = (bf16*)(ws + WS_X);     bf16* XB = (bf16*)(ws + WS_XB); bf16* MG = (bf16*)(ws + WS_MG); float* SSQ = (float*)(ws + WS_SSQ); float* GAM = (float*)(ws + WS_GAM); bf16* SHB = (bf16*)(ws + WS_SHB); bf16* Z = (bf16*)(ws + WS_Z); bf16* Gb = Z; \
    bf16* XBCV = (bf16*)(ws + WS_XBCV); bf16* XCV = (bf16*)(ws + WS_XCV); bf16* YN = (bf16*)(ws + WS_U); bf16* ACC = (bf16*)(ws + WS_AL);     float* AL = (float*)(ws + WS_U + 66 * MiB); float* U = (float*)(ws + WS_U + 68 * MiB);     \
    bf16* OG = (bf16*)(ws + WS_OG); bf16* YS = (bf16*)(ws + WS_YS);     bf16* OA = (bf16*)(ws + WS_OA); bf16* HCG = (bf16*)(ws + WS_HCG); bf16* WADA = (bf16*)(ws + WS_WADA); \
    (void)SC; (void)BIASG; (void)MOD; (void)DT; (void)LSE; (void)X; (void)XB; (void)MG; (void)SSQ; (void)GAM; (void)SHB; (void)Z; (void)Gb; (void)XBCV; (void)XCV; (void)YN; (void)AL; (void)ACC; (void)U; (void)OG; (void)YS; (void)OA; (void)HCG; (void)WADA;
#define PH_LAYER unsigned char* wl = ws + WS_WL + (size_t)l * WL_STRIDE; const float* modl = MOD + (size_t)l * NSEQ * NMOD; \
    (void)wl; (void)modl;

__device__ __forceinline__ void cvt_item(const float* W, int ld, int K, bf16* WT, int dst_row0, LAS float* scr, int k0, int n0, int lane) {
    float wv[32];
#pragma unroll
    for (int i = 0; i < 32; ++i) { const int kk = 2 * i + (lane >> 5); wv[i] = W[(size_t)(k0 + kk) * ld + n0 + (lane & 31)]; }
#pragma unroll
    for (int i = 0; i < 32; ++i) { const int kk = 2 * i + (lane >> 5); scr[kk * 33 + (lane & 31)] = wv[i]; }
    LDS_WAIT(); asm volatile("" ::: "memory");
    const int c = lane & 7;
#pragma unroll
    for (int j = 0; j < 4; ++j) { const int n = (lane >> 3) + 8 * j; const LAS float* s = scr + (8 * c) * 33 + n;
        v4u o; o.x = pk2(s[0 * 33], s[1 * 33]); o.y = pk2(s[2 * 33], s[3 * 33]); o.z = pk2(s[4 * 33], s[5 * 33]); o.w = pk2(s[6 * 33], s[7 * 33]);
        *(v4u*)(WT + (size_t)(dst_row0 + n) * K + k0 + 8 * c) = o; }
    LDS_WAIT(); asm volatile("" ::: "memory");
}
__device__ __forceinline__ void cvt_mat(const float* W, int ld, int K, int ncols, bf16* WT, int mode, int row_off, LAS float* scr, int gw, int NGW, int& rot, int lane, int ldd = 0) {
    const int nblk = ncols / 32, nitems = (K / 64) * nblk; if (ldd == 0) ldd = K;
    int start = gw - (rot % NGW); if (start < 0) start += NGW;
    for (int it = start; it < nitems; it += NGW) {
        const int kb = it / nblk, nb = it - kb * nblk, n0 = 32 * nb;
        int dr;
        if (mode == 0) dr = row_off + n0;
        else { const int isv = n0 >= DFF, j = isv ? n0 - DFF : n0; dr = (j >> 7) * 256 + (isv ? 128 : 0) + (j & 127); }
        cvt_item(W, ld, ldd, WT, dr, scr, 64 * kb, n0, lane);
    }
    rot += nitems;
}

template <int K> __device__ __forceinline__ void sample_resid_units(LAS unsigned char* lds, const bf16* Aop, int lda, const bf16* Bt, int ldb, bf16* X, const float* gate, float scale,
                                                   bf16* XB, float* SSQ, const float* gam, int tid, int vcu, int G) {
    LAS float* P = (LAS float*)lds;
    LAS float* R = P + 8 * 1024;
    const int lane = tid & 63, w = __builtin_amdgcn_readfirstlane(tid >> 6), qq = lane & 15, q4 = lane >> 4;
    for (int un = vcu; un < 256; un += G) {
        const int rt = un >> 4, cs = un & 15, pn = cs >> 2, wc = cs & 3; const size_t row0 = (size_t)NPROMPT + 16 * rt;
        constexpr int kper = K >> 3; const int kbeg = w * kper;
        f32x4 acc[4];
#pragma unroll
        for (int ct = 0; ct < 4; ++ct) acc[ct] = (f32x4){0.f, 0.f, 0.f, 0.f};
        const bf16* ap = Aop + (row0 + qq) * (size_t)lda + kbeg + 8 * q4;
        const bf16* bp = Bt + (size_t)(256 * pn + 32 * wc + qq) * ldb + kbeg + 8 * q4;
#pragma unroll 4
        for (int k0 = 0; k0 < kper; k0 += 32) {
            const bf16x8 af = *(const bf16x8*)(ap + k0);
#pragma unroll
            for (int ct = 0; ct < 4; ++ct) { const bf16x8 bf = *(const bf16x8*)(bp + (size_t)(128 * (ct >> 1) + 16 * (ct & 1)) * ldb + k0);
                acc[ct] = __builtin_amdgcn_mfma_f32_16x16x32_bf16(bf, af, acc[ct], 0, 0, 0); } }
        __syncthreads();
#pragma unroll
        for (int ct = 0; ct < 4; ++ct)
#pragma unroll
            for (int i = 0; i < 4; ++i) P[((w * 4 + ct) * 4 + i) * 64 + lane] = acc[ct][i];
        __syncthreads();
        const int r = tid & 15, ct = tid >> 7, np = (tid >> 4) & 7, i0 = 2 * (np & 1), ln = r + 16 * (np >> 1);
        float s0 = 0.f, s1 = 0.f;
#pragma unroll
        for (int ww = 0; ww < 8; ++ww) { s0 += P[((ww * 4 + ct) * 4 + i0) * 64 + ln]; s1 += P[((ww * 4 + ct) * 4 + i0 + 1) * 64 + ln]; }
        const size_t row = row0 + r; const int sq = 16 + (int)((row - NPROMPT) >> 3);
        const int col = 256 * pn + 128 * (ct >> 1) + 32 * wc + 16 * (ct & 1) + 2 * np;
        const unsigned xw = *(const unsigned*)(X + row * DM + col);
        const float g0 = gate[(size_t)sq * NMOD + col], g1 = gate[(size_t)sq * NMOD + col + 1];
        const float x0 = bflo(xw) + scale * g0 * s0, x1 = bfhi(xw) + scale * g1 * s1;
        *(unsigned*)(X + row * DM + col) = pk2(x0, x1);
        const float m0 = gam[(size_t)sq * DM + col], m1 = gam[(size_t)sq * DM + col + 1];
        *(unsigned*)(XB + row * DM + col) = pk2(x0 * m0, x1 * m1);
        float ss = x0 * x0 + x1 * x1;
        ss += __shfl_xor(ss, 16); ss += __shfl_xor(ss, 32);
        if (lane < 16) R[r * 8 + w] = ss;
        __syncthreads();
        if (tid < 16) { float t = 0.f;
#pragma unroll
            for (int ww = 0; ww < 8; ++ww) t += R[tid * 8 + ww];
            SSQ[(row0 + tid) * 16 + cs] = t; }
    }
    __syncthreads();
}

__device__ __forceinline__ void sample_merge_units(LAS unsigned char* lds, const bf16* OA, const bf16* YN, const bf16* HCG, const bf16* Wa, const bf16* Wb, const bf16* Wc,
                                                   const bf16* Zg, bf16* MG, int tid, int vcu, int G) {
    LAS float* P = (LAS float*)lds;
    const int lane = tid & 63, w = __builtin_amdgcn_readfirstlane(tid >> 6), qq = lane & 15, q4 = lane >> 4;
    for (int un = vcu; un < 256; un += G) {
        const int rt = un >> 4, cs = un & 15, pn = cs >> 2, wc = cs & 3; const size_t row0 = (size_t)NPROMPT + 16 * rt;
        __syncthreads();
#pragma unroll
        for (int pr = 0; pr < 3; ++pr) {
            const bf16* Aop = pr == 0 ? OA : (pr == 1 ? YN : HCG); const bf16* Bt = pr == 0 ? Wa : (pr == 1 ? Wb : Wc); const int K = pr == 0 ? 512 : DM;
            const int kper = K >> 3, kbeg = w * kper;
            f32x4 acc[4];
#pragma unroll
            for (int ct = 0; ct < 4; ++ct) acc[ct] = (f32x4){0.f, 0.f, 0.f, 0.f};
            const bf16* ap = Aop + (row0 + qq) * (size_t)DM + kbeg + 8 * q4;
            const bf16* bp = Bt + (size_t)(256 * pn + 32 * wc + qq) * DM + kbeg + 8 * q4;
#pragma unroll
            for (int k0 = 0; k0 < kper; k0 += 32) {
                const bf16x8 af = *(const bf16x8*)(ap + k0);
#pragma unroll
                for (int ct = 0; ct < 4; ++ct) { const bf16x8 bf = *(const bf16x8*)(bp + (size_t)(128 * (ct >> 1) + 16 * (ct & 1)) * DM + k0);
                    acc[ct] = __builtin_amdgcn_mfma_f32_16x16x32_bf16(bf, af, acc[ct], 0, 0, 0); } }
#pragma unroll
            for (int ct = 0; ct < 4; ++ct)
#pragma unroll
                for (int i = 0; i < 4; ++i) P[pr * 8192 + ((w * 4 + ct) * 4 + i) * 64 + lane] = acc[ct][i];
        }
        __syncthreads();
        const int r = tid & 15, ct = tid >> 7, np = (tid >> 4) & 7, i0 = 2 * (np & 1), ln = r + 16 * (np >> 1);
        const size_t row = row0 + r; const int col = 256 * pn + 128 * (ct >> 1) + 32 * wc + 16 * (ct & 1) + 2 * np;
        float o0 = 0.f, o1 = 0.f;
#pragma unroll
        for (int pr = 0; pr < 3; ++pr) { float s0 = 0.f, s1 = 0.f;
#pragma unroll
            for (int ww = 0; ww < 8; ++ww) { s0 += P[pr * 8192 + ((ww * 4 + ct) * 4 + i0) * 64 + ln]; s1 += P[pr * 8192 + ((ww * 4 + ct) * 4 + i0 + 1) * 64 + ln]; }
            const unsigned gw = *(const unsigned*)ZP(Zg, row, ZGATE + pr * DM + col);
            o0 += sigmoidf_(bflo(gw)) * s0; o1 += sigmoidf_(bfhi(gw)) * s1; }
        *(unsigned*)(MG + row * DM + col) = pk2(o0, o1);
    }
    __syncthreads();
}

__device__ __forceinline__ void mod_small_units(LAS unsigned char* lds, const bf16* SC, const bf16* WADA, const float* bada, float* MOD, bf16* SHB, int tid, int vcu, int G) {
    LAS float* P = (LAS float*)lds;
    const int lane = tid & 63, w = __builtin_amdgcn_readfirstlane(tid >> 6), qq = lane & 15, q4 = lane >> 4;
    for (int un = vcu; un < 3 * 288; un += G) {
        const int rt = un / 288, cs = un - rt * 288;
        const int kbeg = w * 128;
        f32x4 acc[4];
#pragma unroll
        for (int ct = 0; ct < 4; ++ct) acc[ct] = (f32x4){0.f, 0.f, 0.f, 0.f};
        const bf16* ap = SC + (size_t)(16 * rt + qq) * DM + kbeg + 8 * q4;
        const bf16* bp = WADA + (size_t)(64 * cs + qq) * DM + kbeg + 8 * q4;
#pragma unroll
        for (int k0 = 0; k0 < 128; k0 += 32) {
            const bf16x8 af = *(const bf16x8*)(ap + k0);
#pragma unroll
            for (int ct = 0; ct < 4; ++ct) acc[ct] = __builtin_amdgcn_mfma_f32_16x16x32_bf16(*(const bf16x8*)(bp + (size_t)(16 * ct) * DM + k0), af, acc[ct], 0, 0, 0); }
        __syncthreads();
#pragma unroll
        for (int ct = 0; ct < 4; ++ct)
#pragma unroll
            for (int i = 0; i < 4; ++i) P[((w * 4 + ct) * 4 + i) * 64 + lane] = acc[ct][i];
        __syncthreads();
        const int r = tid & 15, ct = tid >> 7, np = (tid >> 4) & 7, i0 = 2 * (np & 1), ln = r + 16 * (np >> 1);
        float s0 = 0.f, s1 = 0.f;
#pragma unroll
        for (int ww = 0; ww < 8; ++ww) { s0 += P[((ww * 4 + ct) * 4 + i0) * 64 + ln]; s1 += P[((ww * 4 + ct) * 4 + i0 + 1) * 64 + ln]; }
        const int row = 16 * rt + r, c = 64 * cs + 16 * ct + 2 * np;
        const int l = c / NMOD, j = c - l * NMOD, chunk = j >> 10, cj = j & 1023, k = chunk / 3, kind = chunk - 3 * k;
        const float v0 = s0 + bada[c], v1 = s1 + bada[c + 1];
        float* o = MOD + ((size_t)(l * NSEQ + row)) * NMOD + j; o[0] = v0; o[1] = v1;
        if (kind == 0) *(unsigned*)(SHB + ((size_t)(l * 3 + k) * 256 + row) * DM + cj) = pk2(v0, v1);
    }
    __syncthreads();
}

__global__ void __launch_bounds__(NWAVES * 64, 2) fwd(Args args_unused) {
    extern __shared__ __attribute__((aligned(16))) unsigned char lds_raw[];
    LAS unsigned char* const lds0 = (LAS unsigned char*)lds_raw;
    volatile LAS unsigned* MISC = (volatile LAS unsigned*)(lds0 + MISC_OFF);
    const int tid0 = threadIdx.x;
    const int G0 = gridDim.x, bx0 = blockIdx.x;
    const int vcu0 = (G0 % 8 == 0) ? (bx0 % 8) * (G0 / 8) + bx0 / 8 : bx0;
    int lo, hi;
    { KArgs A0 = kargs(); lo = A0->ph_lo; hi = A0->ph_hi; }
    for (int u = tid0; u < (LDS_BYTES - LDSCTL_OFF) / 4; u += NWAVES * 64) ((LAS unsigned*)(lds0 + LDSCTL_OFF))[u] = 0u;
    __syncthreads();
    { KArgs A0 = kargs(); if (A0->use_bar) (void)xcd_barrier_post((unsigned*)(A0->ws + WS_CTL) + CW_BAR + A0->li * XCD_BAR_WORDS, MISC + 8, (int)threadIdx.x); }
#define IN(k) (lo <= (k) && (k) < hi)
#define SEAM(k) do { if (IN(k) && IN((k) + 1)) { KArgs Ab = kargs(); XcdBarrier bar_; bar_.bar = (unsigned*)(Ab->ws + WS_CTL) + CW_BAR + Ab->li * XCD_BAR_WORDS; bar_.x = xb_xcc_id(); bar_.st = MISC + 8; xcd_barrier(bar_, (int)threadIdx.x); } } while (0)
#if defined(PROBE_A)
#define PSCALE(k, v) ((kargs()->li == 1 && (k) == lo) ? 0.f : (v))
#else
#define PSCALE(k, v) (v)
#endif
#if defined(PROBE_A)
#define SUB(k, bit) (!(kargs()->li == 1 && (k) == lo) || ((kargs()->submask >> (bit)) & 1u))
#else
#define SUB(k, bit) true
#endif

    if (IN(0)) {
        PH_PTRS
        LAS float* scr = (LAS float*)(lds + wave * 16384);
        int rot = 0;
        for (int l = 0; l < 2; ++l) {
            unsigned char* wl = ws + WS_WL + (size_t)l * WL_STRIDE;
            cvt_mat(A->in[I_WF1I] + (size_t)l * DM * 2 * DFF, 2 * DFF, DM, 2 * DFF, (bf16*)(wl + WL_F1I), 1, 0, scr, gw, NGW, rot, lane);
            cvt_mat(A->in[I_WF1O] + (size_t)l * DFF * DM, DM, DFF, DM, (bf16*)(wl + WL_F1O), 0, 0, scr, gw, NGW, rot, lane);
            cvt_mat(A->in[I_WIN] + (size_t)l * DM * NIN, NIN, DM, 7168, (bf16*)(wl + WL_IN), 0, 0, scr, gw, NGW, rot, lane);
            cvt_mat(A->in[I_WIN] + (size_t)l * DM * NIN + 7184, NIN, DM, NIN - 7184, (bf16*)(wl + WL_IN), 0, 7168, scr, gw, NGW, rot, lane);
            cvt_mat(A->in[I_WA] + (size_t)l * 512 * DM, DM, 512, DM, (bf16*)(wl + WL_A), 0, 0, scr, gw, NGW, rot, lane, DM);
            cvt_mat(A->in[I_WB] + (size_t)l * DM * DM, DM, DM, DM, (bf16*)(wl + WL_B), 0, 0, scr, gw, NGW, rot, lane);
            cvt_mat(A->in[I_WC] + (size_t)l * DM * DM, DM, DM, DM, (bf16*)(wl + WL_C), 0, 0, scr, gw, NGW, rot, lane);
            cvt_mat(A->in[I_WO] + (size_t)l * DM * DM, DM, DM, DM, (bf16*)(wl + WL_O), 0, 0, scr, gw, NGW, rot, lane);
            cvt_mat(A->in[I_WF2I] + (size_t)l * DM * 2 * DFF, 2 * DFF, DM, 2 * DFF, (bf16*)(wl + WL_F2I), 1, 0, scr, gw, NGW, rot, lane);
            cvt_mat(A->in[I_WF2O] + (size_t)l * DFF * DM, DM, DFF, DM, (bf16*)(wl + WL_F2O), 0, 0, scr, gw, NGW, rot, lane);
            for (int hb = 0; hb < 8; ++hb) {
                cvt_mat(A->in[I_WR] + (size_t)(l * 8 + hb) * 16384, 128, 128, 128, (bf16*)(wl + WL_G), 0, hb * 256, scr, gw, NGW, rot, lane);
                cvt_mat(A->in[I_WI] + (size_t)(l * 8 + hb) * 16384, 128, 128, 128, (bf16*)(wl + WL_G), 0, hb * 256 + 128, scr, gw, NGW, rot, lane);
            }
            cvt_mat(A->in[I_WADA] + (size_t)l * DM * NMOD, NMOD, DM, NMOD, WADA, 0, l * NMOD, scr, gw, NGW, rot, lane);
        }
        for (int i = bx * 512 + tid; i < 256 * DM; i += G * 512) { const int s = i >> 10, k = i & 1023;
            float v = 0.f; if (s < 16) v = siluf_(A->in[I_CP][s * DM + k]); else if (s < NSEQ) v = siluf_(A->in[I_CS][(s - 16) * DM + k]);
            SC[i] = (bf16)f2bf(v); }
        for (int i = bx * 512 + tid; i < 24 * 129; i += G * 512) { const int gh = i / 129, j = i - gh * 129, g = gh >> 3; const int dil = g == 0 ? 1 : (g == 1 ? 4 : 16);
            const int dist = j * dil; int bucket;
            if (dist < 16) bucket = dist; else { const int lg = 16 + (int)(log((double)dist / 16.0) / log(128.0) * 16.0); bucket = lg < 31 ? lg : 31; }
            BIASG[gh * 132 + j] = A->in[I_RELB][bucket * 24 + gh]; }
        for (int i = bx * 512 + tid; i < 2 * DM; i += G * 512) ((float*)(ws + WS_SPL))[i] = -8.f * softplusf_(-A->in[I_LAM][i]);
        for (int i = bx * 512 + tid; i < 2 * 256 * DM; i += G * 512) { const int l = i / (256 * DM), r = (i >> 10) & 255, k = i & 1023;
            const float v = r < 16 ? A->in[I_WIN][(size_t)l * DM * NIN + (size_t)k * NIN + 7168 + r] : 0.f;
            ((bf16*)(ws + WS_WL + (size_t)l * WL_STRIDE + WL_IN))[(size_t)(NZ + r) * DM + k] = (bf16)f2bf(v); }
        for (int i = bx * 512 + tid; i < 2 * 3 * 256 * DM / 8; i += G * 512) ((v4u*)SHB)[i] = (v4u){0u, 0u, 0u, 0u};
    }
    SEAM(0);
    if (IN(1)) {
        PH_PTRS
        mod_small_units(lds, SC, WADA, A->in[I_BADA], MOD, SHB, tid, vcu, G);
    }
    SEAM(1);
    if (IN(2)) {
        PH_PTRS
        int rotc = 0;
#pragma unroll 1
        for (int l = 0; l < 2; ++l) {
            unsigned char* wl = ws + WS_WL + (size_t)l * WL_STRIDE;
            { pg8::Gemm g{SHB + (size_t)(l * 3 + 0) * 256 * DM, (const bf16*)(wl + WL_F1I), 256, 2 * DFF, DM, DM, DM, 0}; pg8::StaticOrder S; S.init(256, 2 * DFF, G, (bx + G - rotc % G) % G);
              pg8::EpiShw E{(float*)(ws + WS_SHW1) + (size_t)l * NSEQ * 2 * DFF, 2 * DFF}; pg8::gemm_phase<pg8::EpiShw, pg8::StaticOrder>(lds, g, S, E); rotc += 22; }
            { pg8::Gemm g{SHB + (size_t)(l * 3 + 1) * 256 * DM, (const bf16*)(wl + WL_IN), 256, NZT, DM, DM, DM, 0}; pg8::StaticOrder S; S.init(256, NZT, G, (bx + G - rotc % G) % G);
              pg8::EpiShw E{(float*)(ws + WS_SHW2) + (size_t)l * NSEQ * NZT, NZT}; pg8::gemm_phase<pg8::EpiShw, pg8::StaticOrder>(lds, g, S, E); rotc += 49; }
            { pg8::Gemm g{SHB + (size_t)(l * 3 + 2) * 256 * DM, (const bf16*)(wl + WL_F2I), 256, 2 * DFF, DM, DM, DM, 0}; pg8::StaticOrder S; S.init(256, 2 * DFF, G, (bx + G - rotc % G) % G);
              pg8::EpiShw E{(float*)(ws + WS_SHW3) + (size_t)l * NSEQ * 2 * DFF, 2 * DFF}; pg8::gemm_phase<pg8::EpiShw, pg8::StaticOrder>(lds, g, S, E); rotc += 22; }
        }
        for (int i = bx * 512 + tid; i < 2 * 3 * NSEQ * DM; i += G * 512) { const int c = i & 1023, sq = (i >> 10) % NSEQ, lk = i / (NSEQ * DM), l = lk / 3, k = lk - 3 * l;
            const float* gk = A->in[k == 0 ? I_GFF1 : (k == 1 ? I_GMIX : I_GFF2)] + l * DM;
            GAM[i] = gk[c] * (1.f + MOD[((size_t)(l * NSEQ + sq)) * NMOD + (3 * k + 1) * DM + c]); }
        { f32x4 gf[4];
#pragma unroll
          for (int j = 0; j < 4; ++j) gf[j] = *(const f32x4*)(A->in[I_GFF1] + 4 * (lane + 64 * j));
          for (int row0 = gw; row0 < M; row0 += 2 * NGW) {
            f32x4 xv[2][4], mv[2][4];
#pragma unroll
            for (int k = 0; k < 2; ++k) { const int row = row0 + k * NGW;
#pragma unroll
                for (int j = 0; j < 4; ++j) { xv[k][j] = (f32x4){0.f, 0.f, 0.f, 0.f}; mv[k][j] = (f32x4){0.f, 0.f, 0.f, 0.f}; }
                if (row < M) {
                    const float* xr = row < NPROMPT ? A->in[I_XP] + (size_t)row * DM : A->in[I_XS] + (size_t)(row - NPROMPT) * DM;
                    const float* mr = MOD + (size_t)seq_of_row(row) * NMOD + DM;
#pragma unroll
                    for (int j = 0; j < 4; ++j) { const int c = 4 * (lane + 64 * j); xv[k][j] = *(const f32x4*)(xr + c); mv[k][j] = *(const f32x4*)(mr + c); } } }
#pragma unroll
            for (int k = 0; k < 2; ++k) { const int row = row0 + k * NGW;
                if (row < M) {
                    float ss = 0.f;
#pragma unroll
                    for (int j = 0; j < 4; ++j) { const int c = 4 * (lane + 64 * j); const f32x4 v = xv[k][j];
                        ss += (v.x * v.x + v.y * v.y) + (v.z * v.z + v.w * v.w); { v2u xs_; xs_.x = pk2(v.x, v.y); xs_.y = pk2(v.z, v.w); *(v2u*)(X + (size_t)row * DM + c) = xs_; }
                        const f32x4 y = v * gf[j] * (mv[k][j] + 1.f);
                        v2u w; w.x = pk2(y.x, y.y); w.y = pk2(y.z, y.w); *(v2u*)(XB + (size_t)row * DM + c) = w; }
                    ss = wave_sum(ss);
                    if (lane < 16) SSQ[(size_t)row * 16 + lane] = lane == 0 ? ss : 0.f; } }
          } }
    }
    SEAM(2);

#pragma clang loop unroll(full)
    for (int l = 0; l < 2; ++l) {
        const int pb = PH_L0 + NPH_LAYER * l;
        if (IN(pb + 0)) {
            PH_PTRS PH_LAYER
            pg8::Gemm g{XB, (const bf16*)(wl + WL_F1I), M, 2 * DFF, DM, DM, DM, 0}; pg8::HalfOrder S; S.init(2 * DFF, G, bx);
            pg8::EpiSwiGLU E{Gb, SSQ, (const float*)(ws + WS_SHW1) + (size_t)l * NSEQ * 2 * DFF};
            pg8::gemm_phase<pg8::EpiSwiGLU, pg8::HalfOrder>(lds, g, S, E);
        }
        SEAM(pb + 0);
        if (IN(pb + 1)) {
            PH_PTRS PH_LAYER
            sample_resid_units<DFF>(lds, Gb, DFF, (const bf16*)(wl + WL_F1O), DFF, X, modl + 2 * DM, PSCALE(pb + 1, 0.5f), XB, SSQ, GAM + (size_t)(l * 3 + 1) * NSEQ * DM, tid, vcu, G);
            pg8::Gemm g{Gb, (const bf16*)(wl + WL_F1O), M, DM, DFF, DFF, DFF, 0}; pg8::StaticOrder S; S.init(NPROMPT, DM, G, bx);
            pg8::EpiResid<true> E{X, modl + 2 * DM, PSCALE(pb + 1, 0.5f), XB, SSQ, GAM + (size_t)(l * 3 + 1) * NSEQ * DM};
            pg8::gemm_phase<pg8::EpiResid<true>, pg8::StaticOrder>(lds, g, S, E);
        }
        SEAM(pb + 1);
        if (IN(pb + 2)) {
            PH_PTRS PH_LAYER
            pg8::Gemm g{XB, (const bf16*)(wl + WL_IN), M, NZT, DM, DM, DM, 0}; pg8::StaticOrder S; S.init(M, NZT, G, bx);
            pg8::EpiZ E{Z, SSQ, (const float*)(ws + WS_SHW2) + (size_t)l * NSEQ * NZT, out, DT, A->in[I_DTB] + l * 16, l};
            pg8::gemm_phase<pg8::EpiZ, pg8::StaticOrder>(lds, g, S, E);
        }
        SEAM(pb + 2);
        if (IN(pb + 3)) {
            PH_PTRS PH_LAYER
            if (SUB(pb + 3, 0)) {
                const int nitems = (M / 16) * 5;
#pragma unroll 1
                for (int it = gw; it < nitems; it += NGW) {
                    const int seg = it / 5, c = (it - seg * 5) * 64 + lane;
                    if (c >= 192 && seg * 16 < NPROMPT) continue;
                    const bool isB = c < 192; const int col = isB ? 8 * c : 8 * (c - 192); const int zc = isB ? ZXBC + col : ZXC + col; const int nch = isB ? 1536 : 1024;
                    const float* cwp = (isB ? A->in[I_CBW] + (size_t)l * 4 * 1536 : A->in[I_CCW] + (size_t)l * 4 * 1024) + col;
                    const float* cbp = (isB ? A->in[I_CBB] + (size_t)l * 1536 : A->in[I_CCB] + (size_t)l * 1024) + col;
                    float cw[4][8], cb[8];
#pragma unroll
                    for (int e = 0; e < 8; ++e) { cb[e] = cbp[e];
#pragma unroll
                        for (int j = 0; j < 4; ++j) cw[j][e] = cwp[j * nch + e]; }
                    const int r0 = seg * 16; const bool isS = r0 >= NPROMPT; const int t0 = isS ? 0 : (r0 & (SEQ - 1));
                    float win[3][8];
#pragma unroll
                    for (int j = 0; j < 3; ++j) {
                        if (!isS && t0 >= 3) { unpack8(*(const v4u*)ZP(Z, r0 - 3 + j, zc), win[j]); }
                        else {
#pragma unroll
                            for (int e = 0; e < 8; ++e) win[j][e] = 0.f; } }
                    v4u rw[16];
#pragma unroll
                    for (int i = 0; i < 16; ++i) rw[i] = *(const v4u*)ZP(Z, r0 + i, zc);
#pragma unroll
                    for (int i = 0; i < 16; ++i) { const int row = r0 + i; const int t = isS ? (i & 7) : t0 + i;
                        float cur[8]; unpack8(rw[i], cur);
                        if (isS && t < 3) {
                            const float* st = (isB ? A->in[I_SCB] + (size_t)(l * 32 + ((row - NPROMPT) >> 3)) * 3 * 1536 : A->in[I_SCC] + (size_t)(l * 32 + ((row - NPROMPT) >> 3)) * 3 * 1024) + col;
#pragma unroll
                            for (int j = 0; j < 3; ++j) { const int tt = t - 3 + j;
                                if (tt < 0) {
#pragma unroll
                                    for (int e = 0; e < 8; ++e) win[j][e] = st[(size_t)(3 + tt) * nch + e]; } } }
                        float a8[8];
#pragma unroll
                        for (int e = 0; e < 8; ++e) { a8[e] = cb[e] + cw[0][e] * win[0][e] + cw[1][e] * win[1][e] + cw[2][e] * win[2][e] + cw[3][e] * cur[e];
                            win[0][e] = win[1][e]; win[1][e] = win[2][e]; win[2][e] = cur[e]; }
                        if (isB) {
#pragma unroll
                            for (int e = 0; e < 8; ++e) a8[e] = siluf_(a8[e]);
                            *(v4u*)(XBCV + (size_t)row * 1536 + col) = pack8(a8); }
                        else *(v4u*)(XCV + (size_t)row * DM + col) = pack8(a8);
                    }
                }
            }
            if (SUB(pb + 3, 1)) {
                LAS unsigned char* KB0 = lds; LAS unsigned char* VB0 = lds + 65536; LAS float* bsm = (LAS float*)(lds + 131072);
                const int qq = lane & 15, q4 = lane >> 4, w = wave;
                constexpr int NUN = 16 * 3 * 8 * 16;
#define ATT_DECODE(un_) const int blk = (un_) & 15, hh = ((un_) >> 4) & 7, g = ((un_) >> 7) % 3, b = (un_) / 384; \
                    const int dil = g == 0 ? 1 : (g == 1 ? 4 : 16), nbr = 16 / dil, r = blk / nbr, qb = blk - r * nbr, i0 = qb * 128; const size_t rowb = (size_t)b * SEQ;
#define ATT_ISSUE(un_, bi_, qdst) do { ATT_DECODE(un_) \
                    _Pragma("unroll") for (int k = 0; k < 4; ++k) { const int rb = k * 8 + w, row = 8 * rb + (lane >> 3), ch = (lane & 7) ^ (row & 7); int si = i0 - 128 + row; si = si < 0 ? 0 : si; \
                        const size_t zr_ = rowb + (size_t)si * dil + r; const int zc_ = g * 512 + hh * 64 + ch * 8; \
                        __builtin_amdgcn_global_load_lds((const unsigned*)ZP(Z, zr_, ZK + zc_), (LAS unsigned*)(KB0 + (bi_) * 32768 + rb * 1024), 16, 0, 0); \
                        __builtin_amdgcn_global_load_lds((const unsigned*)ZP(Z, zr_, ZV + zc_), (LAS unsigned*)(VB0 + (bi_) * 32768 + rb * 1024), 16, 0, 0); } \
                    { const bf16* qp = ZP(Z, rowb + (size_t)(i0 + 16 * w + qq) * dil + r, ZQ + g * 512 + hh * 64 + 8 * q4); qdst[0] = *(const bf16x8*)qp; qdst[1] = *(const bf16x8*)(qp + 32); } \
                    bnx = 0.f; if (tid < 129) bnx = BIASG[(g * 8 + hh) * 132 + tid]; } while (0)
                bf16x8 qn[2] = {(bf16x8){0, 0, 0, 0, 0, 0, 0, 0}, (bf16x8){0, 0, 0, 0, 0, 0, 0, 0}}; float bnx = 0.f;
                __syncthreads();
                if (vcu < NUN) ATT_ISSUE(vcu, 0, qn);
                int it = 0;
                for (int un = vcu; un < NUN; un += G, ++it) {
                    ATT_DECODE(un)
                    const int bi = it & 1;
                    if (it == 0) asm volatile("s_waitcnt vmcnt(0)" ::: "memory");
                    else asm volatile("s_waitcnt vmcnt(4)" ::: "memory");
                    if (tid < 129) bsm[bi * 132 + tid] = bnx;
                    asm volatile("s_waitcnt lgkmcnt(0)\n\ts_barrier" ::: "memory");
                    bf16x8 qf[2]; qf[0] = qn[0]; qf[1] = qn[1];
                    if (un + G < NUN) ATT_ISSUE(un + G, bi ^ 1, qn);
                    const LAS unsigned char* Kb = KB0 + bi * 32768; const LAS unsigned char* Vb = VB0 + bi * 32768; const LAS float* bias = bsm + bi * 132;
                    f32x4 sacc[9];
#pragma unroll
                    for (int kr = 0; kr < 9; ++kr) sacc[kr] = (f32x4){0.f, 0.f, 0.f, 0.f};
                    { bf16x8 kf[9][2];
#pragma unroll
                      for (int kr = 0; kr < 9; ++kr) { const int row = 16 * (w + kr) + qq;
#pragma unroll
                          for (int s2 = 0; s2 < 2; ++s2) kf[kr][s2] = *(const LAS bf16x8*)(Kb + row * 128 + (((4 * s2 + q4) ^ (row & 7)) << 4)); }
#pragma unroll
                      for (int kr = 0; kr < 9; ++kr)
#pragma unroll
                          for (int s2 = 0; s2 < 2; ++s2) sacc[kr] = __builtin_amdgcn_mfma_f32_16x16x32_bf16(kf[kr][s2], qf[s2], sacc[kr], 0, 0, 0); }
                    float mx = -INFINITY;
#pragma unroll
                    for (int kr = 0; kr < 9; ++kr)
#pragma unroll
                        for (int i = 0; i < 4; ++i) { const int dist = 128 + qq - 16 * kr - 4 * q4 - i; const int si = i0 - 128 + 16 * (w + kr) + 4 * q4 + i;
                            const bool valid = dist >= 0 && dist <= 128 && si >= 0;
                            const float bv = bias[dist < 0 ? 0 : (dist > 128 ? 128 : dist)];
                            const float lgu = sacc[kr][i] * 0.125f + bv; const float lg = valid ? lgu : -INFINITY; sacc[kr][i] = lg; mx = fmaxf(mx, lg); }
                    mx = fmaxf(mx, __shfl_xor(mx, 16)); mx = fmaxf(mx, __shfl_xor(mx, 32));
                    float sm = 0.f;
#pragma unroll
                    for (int kr = 0; kr < 9; ++kr)
#pragma unroll
                        for (int i = 0; i < 4; ++i) { const float p = __expf(sacc[kr][i] - mx); sacc[kr][i] = p; sm += p; }
                    sm += __shfl_xor(sm, 16); sm += __shfl_xor(sm, 32);
                    f32x4 oacc[4];
#pragma unroll
                    for (int dt = 0; dt < 4; ++dt) oacc[dt] = (f32x4){0.f, 0.f, 0.f, 0.f};
                    typedef short v4i16_t __attribute__((ext_vector_type(4)));
#pragma unroll
                    for (int st = 0; st < 5; ++st) {
                        const int ka = 2 * st, kb2 = (2 * st + 1 < 9) ? 2 * st + 1 : 2 * st;
                        v4u pw; pw.x = pk2(sacc[ka][0], sacc[ka][1]); pw.y = pk2(sacc[ka][2], sacc[ka][3]);
                        if (2 * st + 1 < 9) { pw.z = pk2(sacc[kb2][0], sacc[kb2][1]); pw.w = pk2(sacc[kb2][2], sacc[kb2][3]); } else { pw.z = 0u; pw.w = 0u; }
                        const bf16x8 pf = __builtin_bit_cast(bf16x8, pw);
                        const int rwa = 16 * (w + ka) + 4 * q4 + (qq >> 2), rwb = 16 * (w + kb2) + 4 * q4 + (qq >> 2);
#pragma unroll
                        for (int dt = 0; dt < 4; ++dt) { const int chv = 2 * dt + ((qq & 3) >> 1);
                            const v2u lo2 = __builtin_bit_cast(v2u, __builtin_amdgcn_ds_read_tr16_b64_v4i16((LAS v4i16_t*)(Vb + rwa * 128 + ((chv ^ (rwa & 7)) << 4) + 8 * (qq & 1))));
                            const v2u hi2 = __builtin_bit_cast(v2u, __builtin_amdgcn_ds_read_tr16_b64_v4i16((LAS v4i16_t*)(Vb + rwb * 128 + ((chv ^ (rwb & 7)) << 4) + 8 * (qq & 1))));
                            v4u vw; vw.x = lo2.x; vw.y = lo2.y; vw.z = hi2.x; vw.w = hi2.y;
                            oacc[dt] = __builtin_amdgcn_mfma_f32_16x16x32_bf16(__builtin_bit_cast(bf16x8, vw), pf, oacc[dt], 0, 0, 0); }
                    }
                    const float inv = rcpf_(sm);
                    const size_t orow = rowb + (size_t)(i0 + 16 * w + qq) * dil + r;
                    bf16* op = OG + ((size_t)g * M + orow) * 512 + hh * 64 + 4 * q4;
#pragma unroll
                    for (int dt = 0; dt < 4; ++dt) { v2u ow; ow.x = pk2(oacc[dt][0] * inv, oacc[dt][1] * inv); ow.y = pk2(oacc[dt][2] * inv, oacc[dt][3] * inv); *(v2u*)(op + 16 * dt) = ow; }
                    if (q4 == 0) LSE[((size_t)g * M + orow) * 8 + hh] = mx + __logf(sm);
                }
                asm volatile("s_waitcnt vmcnt(0) lgkmcnt(0)" ::: "memory");
                __syncthreads();
            }
            if (SUB(pb + 3, 2)) {
                LAS float* pbuf = (LAS float*)(lds + 98304) + wave * 136;
                for (int un = gw; un < 32 * 8 * 3 * 8; un += NGW) {
                    const int hh = un & 7, g = (un >> 3) % 3, t = (un / 24) & 7, sb = un / 192;
                    const int dil = g == 0 ? 1 : (g == 1 ? 4 : 16), wb = g == 0 ? 128 : (g == 1 ? 512 : 2048);
                    const float* cache = A->in[g == 0 ? I_KV1 : (g == 1 ? I_KV2 : I_KV3)] + (size_t)(l * 32 + sb) * wb * 1024;
                    const size_t rowS = (size_t)NPROMPT + sb * 8;
                    const bf16* qp = ZP(Z, rowS + t, ZQ + g * 512 + hh * 64);
                    float q[64];
#pragma unroll
                    for (int c = 0; c < 8; ++c) { float tmp[8]; unpack8(*(const v4u*)(qp + 8 * c), tmp);
#pragma unroll
                        for (int e = 0; e < 8; ++e) q[8 * c + e] = tmp[e]; }
                    const float* bias = BIASG + (g * 8 + hh) * 132;
                    float sc3[3] = {-INFINITY, -INFINITY, -INFINITY};
#pragma unroll 1
                    for (int jj = 0; jj < 3; ++jj) { const int j = 64 * jj + lane; float s = -INFINITY;
                        if (j <= 128) { const int idx = wb + t - dil * j; float d = 0.f;
                            if (idx >= wb) { const bf16* kp = ZP(Z, rowS + (idx - wb), ZK + g * 512 + hh * 64);
#pragma unroll
                                for (int c = 0; c < 8; ++c) { float tmp[8]; unpack8(*(const v4u*)(kp + 8 * c), tmp);
#pragma unroll
                                    for (int e = 0; e < 8; ++e) d += q[8 * c + e] * tmp[e]; } }
                            else { const float* kp = cache + (size_t)idx * 1024 + hh * 64;
#pragma unroll
                                for (int c = 0; c < 16; ++c) { const f32x4 k4 = *(const f32x4*)(kp + 4 * c); d += (q[4 * c] * k4.x + q[4 * c + 1] * k4.y) + (q[4 * c + 2] * k4.z + q[4 * c + 3] * k4.w); } }
                            s = d * 0.125f + bias[j]; }
                        sc3[0] = jj == 0 ? s : sc3[0]; sc3[1] = jj == 1 ? s : sc3[1]; sc3[2] = jj == 2 ? s : sc3[2]; }
                    const float mx = wave_max(fmaxf(fmaxf(sc3[0], sc3[1]), sc3[2]));
                    float sm = 0.f;
#pragma unroll
                    for (int jj = 0; jj < 3; ++jj) { const int j = 64 * jj + lane; const float p = (j <= 128) ? __expf(sc3[jj] - mx) : 0.f; sm += p; if (j <= 128) pbuf[j] = p; }
                    sm = wave_sum(sm);
                    LDS_WAIT(); asm volatile("" ::: "memory");
                    float o = 0.f;
                    const int jn = t / dil + 1;
                    for (int j = 0; j < jn; ++j) o += pbuf[j] * bf2f(*ZP(Z, rowS + (t - dil * j), ZV + g * 512 + hh * 64 + lane));
                    { const float* vc = cache + (size_t)(wb + t) * 1024 + 512 + hh * 64 + lane; const size_t vstep = (size_t)dil * 1024;
#pragma unroll 8
                      for (int j = jn; j <= 128; ++j) o += pbuf[j] * vc[-(ptrdiff_t)(j * vstep)]; }
                    OG[((size_t)g * M + rowS + t) * 512 + hh * 64 + lane] = (bf16)f2bf(o * rcpf_(sm));
                    if (lane == 0) LSE[((size_t)g * M + rowS + t) * 8 + hh] = mx + __logf(sm);
                    LDS_WAIT(); asm volatile("" ::: "memory");
                }
                __syncthreads();
            }
        }
        SEAM(pb + 3);
        if (IN(pb + 4)) {
            PH_PTRS PH_LAYER
            if (SUB(pb + 4, 0)) {
                const bf16* wg = (const bf16*)(wl + WL_G); const int qq = lane & 15, q4 = lane >> 4;
                for (int un = gw; un < 16 * 8 * 4; un += NGW) {
                    const int rt = un >> 5, j = (un >> 2) & 7, qd = un & 3, ch0 = j * 128 + 32 * qd;
                    const bf16* ap = XCV + ((size_t)NPROMPT + 16 * rt + qq) * DM + j * 128 + 8 * q4;
                    f32x4 ga[4];
#pragma unroll
                    for (int ct = 0; ct < 4; ++ct) ga[ct] = (f32x4){0.f, 0.f, 0.f, 0.f};
#pragma unroll
                    for (int ks = 0; ks < 4; ++ks) { const bf16x8 xf = *(const bf16x8*)(ap + 32 * ks);
#pragma unroll
                        for (int ct = 0; ct < 4; ++ct) { const int wrow = j * 256 + (ct >> 1) * 128 + 32 * qd + 16 * (ct & 1) + qq;
                            ga[ct] = __builtin_amdgcn_mfma_f32_16x16x32_bf16(*(const bf16x8*)(wg + (size_t)wrow * 128 + 32 * ks + 8 * q4), xf, ga[ct], 0, 0, 0); } }
#pragma unroll
                    for (int h2 = 0; h2 < 2; ++h2) { const int ch = ch0 + 16 * h2 + 4 * q4; const size_t row = (size_t)16 * rt + qq;
                        const f32x4 brv = *(const f32x4*)(A->in[I_BR] + l * DM + ch), biv = *(const f32x4*)(A->in[I_BI] + l * DM + ch), sp = *(const f32x4*)((const float*)(ws + WS_SPL) + l * DM + ch);
                        const v2u xw = *(const v2u*)(XCV + ((size_t)NPROMPT + row) * DM + ch); const float xv[4] = {bflo(xw.x), bfhi(xw.x), bflo(xw.y), bfhi(xw.y)};
                        f32x4 av, uv;
#pragma unroll
                        for (int i = 0; i < 4; ++i) { const float rg = sigmoidf_(ga[h2][i] + brv[i]), ig = sigmoidf_(ga[2 + h2][i] + biv[i]); const float la = sp[i] * rg;
                            av[i] = __expf(la); uv[i] = xv[i] * ig * __builtin_amdgcn_sqrtf(one_minus_exp(2.f * la)); }
                        *(f32x4*)(AL + row * DM + ch) = av; *(f32x4*)(U + row * DM + ch) = uv; }
                }
            }
            __syncthreads();
            if (SUB(pb + 4, 1)) {
                constexpr int ST = 136, SX = 72;
                LAS bf16* xs = (LAS bf16*)lds;
                LAS bf16* Bsm = xs + 128 * SX;
                LAS bf16* Bw = Bsm + 128 * ST;
                LAS bf16* Csm = Bw + 128 * ST;
                LAS bf16* hT = Csm + 128 * ST;
                LAS float* acum = (LAS float*)(hT + 128 * SX);
                LAS float* dtl = acum + 128;
                static_assert((128 * SX * 2 + 3 * 128 * ST) * 2 + 1024 <= LDSCTL_OFF, "SSD LDS map");
                const int qq = lane & 15, q4 = lane >> 4, w = wave, lrow = 16 * w + qq;
                for (int un = vcu; un < 256; un += G) {
                    const int b = un >> 4, hd = un & 15, gq = hd >> 3;
                    const float aneg = -__expf(A->in[I_ALOG][l * 16 + hd]), Dsk = A->in[I_DSKIP][l * 16 + hd];
                    f32x4 hacc[4];
#pragma unroll
                    for (int pt = 0; pt < 4; ++pt) hacc[pt] = (f32x4){0.f, 0.f, 0.f, 0.f};
#define SSD_LOAD(c_) do { const size_t r0_ = (size_t)b * SEQ + 128 * (c_); \
                        _Pragma("unroll") for (int k = 0; k < 2; ++k) { const int idx = tid + 512 * k, s_ = idx >> 3, part = idx & 7; xr[k] = *(const v4u*)(XBCV + (r0_ + s_) * 1536 + hd * 64 + part * 8); } \
                        _Pragma("unroll") for (int k = 0; k < 4; ++k) { const int idx = tid + 512 * k, s_ = idx >> 4, part = idx & 15; const bf16* bp = XBCV + (r0_ + s_) * 1536 + 1024 + gq * 128 + part * 8; \
                            br[k] = *(const v4u*)bp; cr[k] = *(const v4u*)(bp + 256); } \
                        dtv = 0.f; if (tid < 128) dtv = DT[(r0_ + tid) * 16 + hd]; } while (0)
                    v4u xr[2] = {(v4u){0u, 0u, 0u, 0u}, (v4u){0u, 0u, 0u, 0u}}, br[4] = {(v4u){0u, 0u, 0u, 0u}, (v4u){0u, 0u, 0u, 0u}, (v4u){0u, 0u, 0u, 0u}, (v4u){0u, 0u, 0u, 0u}}, cr[4] = {(v4u){0u, 0u, 0u, 0u}, (v4u){0u, 0u, 0u, 0u}, (v4u){0u, 0u, 0u, 0u}, (v4u){0u, 0u, 0u, 0u}}; float dtv = 0.f;
                    SSD_LOAD(0);
#pragma unroll 1
                    for (int c = 0; c < 16; ++c) {
                        const size_t r0 = (size_t)b * SEQ + 128 * c;
                        LBAR();
                        if (tid < 128) dtl[tid] = dtv;
#pragma unroll
                        for (int pt = 0; pt < 4; ++pt) { v2u hw; hw.x = pk2(hacc[pt][0], hacc[pt][1]); hw.y = pk2(hacc[pt][2], hacc[pt][3]); *(LAS v2u*)(hT + lrow * SX + 16 * pt + 4 * q4) = hw; }
#pragma unroll
                        for (int k = 0; k < 2; ++k) { const int idx = tid + 512 * k, s_ = idx >> 3, part = idx & 7; *(LAS v4u*)(xs + s_ * SX + part * 8) = xr[k]; }
#pragma unroll
                        for (int k = 0; k < 4; ++k) { const int idx = tid + 512 * k, s_ = idx >> 4, part = idx & 15; *(LAS v4u*)(Bsm + s_ * ST + part * 8) = br[k]; *(LAS v4u*)(Csm + s_ * ST + part * 8) = cr[k]; }
                        LBAR();
                        if (w == 0) { const float a0 = dtl[2 * lane] * aneg, a1 = dtl[2 * lane + 1] * aneg; const float sp = a0 + a1; float v = sp;
#pragma unroll
                            for (int o = 1; o < 64; o <<= 1) { const float t = __shfl_up(v, o); if (lane >= o) v += t; }
                            acum[2 * lane] = v - sp + a0; acum[2 * lane + 1] = v; }
                        LBAR();
                        const float alast = acum[127];
#pragma unroll
                        for (int k = 0; k < 4; ++k) { const int idx = tid + 512 * k, s_ = idx >> 4, part = idx & 15; const float wg = dtl[s_] * __expf(alast - acum[s_]);
                            float bv[8]; unpack8(br[k], bv);
#pragma unroll
                            for (int e = 0; e < 8; ++e) bv[e] *= wg;
                            *(LAS v4u*)(Bw + s_ * ST + part * 8) = pack8(bv); }
                        if (c < 15) SSD_LOAD(c + 1);
                        LBAR();
                        bf16x8 cf[4];
#pragma unroll
                        for (int ks = 0; ks < 4; ++ks) cf[ks] = *(const LAS bf16x8*)(Csm + lrow * ST + 32 * ks + 8 * q4);
                        f32x4 yacc[4];
#pragma unroll
                        for (int pt = 0; pt < 4; ++pt) { yacc[pt] = (f32x4){0.f, 0.f, 0.f, 0.f};
#pragma unroll
                            for (int ks = 0; ks < 4; ++ks) { const v2u a0 = tr_read(hT, SX, 32 * ks + 8 * q4, 16 * pt, qq), a1 = tr_read(hT, SX, 32 * ks + 8 * q4 + 4, 16 * pt, qq);
                                v4u aw; aw.x = a0.x; aw.y = a0.y; aw.z = a1.x; aw.w = a1.y; yacc[pt] = __builtin_amdgcn_mfma_f32_16x16x32_bf16(__builtin_bit_cast(bf16x8, aw), cf[ks], yacc[pt], 0, 0, 0); } }
                        const float al = acum[lrow], el = __expf(al);
#pragma unroll
                        for (int pt = 0; pt < 4; ++pt) yacc[pt] = yacc[pt] * el;
                        f32x4 cb[8];
#pragma unroll
                        for (int st = 0; st < 8; ++st) { cb[st] = (f32x4){0.f, 0.f, 0.f, 0.f};
                            if (st <= w) {
#pragma unroll
                                for (int ks = 0; ks < 4; ++ks) { const bf16x8 bfa = *(const LAS bf16x8*)(Bsm + (16 * st + qq) * ST + 32 * ks + 8 * q4); cb[st] = __builtin_amdgcn_mfma_f32_16x16x32_bf16(bfa, cf[ks], cb[st], 0, 0, 0); }
                                const f32x4 as4 = *(const LAS f32x4*)(acum + 16 * st + 4 * q4), ds4 = *(const LAS f32x4*)(dtl + 16 * st + 4 * q4);
#pragma unroll
                                for (int i = 0; i < 4; ++i) { const bool valid = (16 * st + 4 * q4 + i) <= lrow; const float dd = valid ? al - as4[i] : 0.f; cb[st][i] = valid ? cb[st][i] * __expf(dd) * ds4[i] : 0.f; } } }
#pragma unroll
                        for (int j = 0; j < 4; ++j) if (2 * j <= w) {
                            v4u pw; pw.x = pk2(cb[2 * j][0], cb[2 * j][1]); pw.y = pk2(cb[2 * j][2], cb[2 * j][3]); pw.z = pk2(cb[2 * j + 1][0], cb[2 * j + 1][1]); pw.w = pk2(cb[2 * j + 1][2], cb[2 * j + 1][3]);
                            const bf16x8 pf = __builtin_bit_cast(bf16x8, pw);
#pragma unroll
                            for (int pt = 0; pt < 4; ++pt) { const v2u lo2 = tr_read(xs, SX, 32 * j + 4 * q4, 16 * pt, qq), hi2 = tr_read(xs, SX, 32 * j + 16 + 4 * q4, 16 * pt, qq);
                                v4u xw; xw.x = lo2.x; xw.y = lo2.y; xw.z = hi2.x; xw.w = hi2.y;
                                yacc[pt] = __builtin_amdgcn_mfma_f32_16x16x32_bf16(__builtin_bit_cast(bf16x8, xw), pf, yacc[pt], 0, 0, 0); } }
                        { const size_t row = r0 + lrow;
#pragma unroll
                          for (int pt = 0; pt < 4; ++pt) { const v2u xg = *(const v2u*)(XBCV + row * 1536 + hd * 64 + 16 * pt + 4 * q4);
                              f32x4 y = yacc[pt]; y.x += Dsk * bflo(xg.x); y.y += Dsk * bfhi(xg.x); y.z += Dsk * bflo(xg.y); y.w += Dsk * bfhi(xg.y);
                              v2u yw; yw.x = pk2(y.x, y.y); yw.y = pk2(y.z, y.w); *(v2u*)(YS + row * DM + hd * 64 + 16 * pt + 4 * q4) = yw; } }
                        { const float elast = __expf(alast);
#pragma unroll
                          for (int pt = 0; pt < 4; ++pt) hacc[pt] = hacc[pt] * elast;
#pragma unroll
                          for (int ks = 0; ks < 4; ++ks) { const v2u b0 = tr_read(Bw, ST, 32 * ks + 8 * q4, 16 * w, qq), b1 = tr_read(Bw, ST, 32 * ks + 8 * q4 + 4, 16 * w, qq);
                              v4u bw; bw.x = b0.x; bw.y = b0.y; bw.z = b1.x; bw.w = b1.y; const bf16x8 bfb = __builtin_bit_cast(bf16x8, bw);
#pragma unroll
                              for (int pt = 0; pt < 4; ++pt) { const v2u a0 = tr_read(xs, SX, 32 * ks + 8 * q4, 16 * pt, qq), a1 = tr_read(xs, SX, 32 * ks + 8 * q4 + 4, 16 * pt, qq);
                                  v4u aw; aw.x = a0.x; aw.y = a0.y; aw.z = a1.x; aw.w = a1.y; hacc[pt] = __builtin_amdgcn_mfma_f32_16x16x32_bf16(__builtin_bit_cast(bf16x8, aw), bfb, hacc[pt], 0, 0, 0); } } }
                    }
                    float* ho = out + O_PSSM + ((size_t)(l * 16 + b) * 16 + hd) * 8192;
#pragma unroll
                    for (int pt = 0; pt < 4; ++pt)
#pragma unroll
                        for (int i = 0; i < 4; ++i) ho[(16 * pt + 4 * q4 + i) * 128 + lrow] = hacc[pt][i];
                }
                __syncthreads();
            }
            if (SUB(pb + 4, 2)) {
                LAS float* xs = (LAS float*)lds; LAS float* Bs = xs + 64 * 64; LAS float* Cs = Bs + 64 * 128; LAS float* dts = Cs + 64 * 128; LAS float* decs = dts + 64; LAS float* ysb = decs + 64;
                const int p = tid >> 3, ng = tid & 7, n0 = 16 * ng;
                for (int un = 256 + vcu; un < 256 + 512; un += G) {
                    const bool isS = un >= 256; const int sq = isS ? (un - 256) >> 4 : un >> 4, hd = un & 15, gq = hd >> 3;
                    const int L = isS ? 8 : SEQ; const size_t row0 = isS ? (size_t)NPROMPT + sq * 8 : (size_t)sq * SEQ;
                    float hst[16];
                    if (isS) { const float* h0 = A->in[I_SSSM] + ((size_t)(l * 32 + sq) * 16 + hd) * 8192 + p * 128 + n0;
#pragma unroll
                        for (int i = 0; i < 16; ++i) hst[i] = h0[i]; }
                    else {
#pragma unroll
                        for (int i = 0; i < 16; ++i) hst[i] = 0.f; }
                    const float aneg = -__expf(A->in[I_ALOG][l * 16 + hd]), Dsk = A->in[I_DSKIP][l * 16 + hd];
                    for (int t0 = 0; t0 < L; t0 += 64) {
                        const int tc = (L - t0) < 64 ? (L - t0) : 64;
                        __syncthreads();
                        for (int c = tid; c < tc * 40; c += 512) { const int tok = c / 40, part = c - tok * 40;
                            const int col = part < 8 ? hd * 64 + part * 8 : (part < 24 ? 1024 + gq * 128 + (part - 8) * 8 : 1280 + gq * 128 + (part - 24) * 8);
                            float tmp[8]; unpack8(*(const v4u*)(XBCV + (row0 + t0 + tok) * 1536 + col), tmp);
                            LAS float* d = part < 8 ? xs + tok * 64 + part * 8 : (part < 24 ? Bs + tok * 128 + (part - 8) * 8 : Cs + tok * 128 + (part - 24) * 8);
                            *(LAS f32x4*)d = (f32x4){tmp[0], tmp[1], tmp[2], tmp[3]}; *(LAS f32x4*)(d + 4) = (f32x4){tmp[4], tmp[5], tmp[6], tmp[7]}; }
                        if (tid < tc) { const float dtv = DT[(row0 + t0 + tid) * 16 + hd]; dts[tid] = dtv; decs[tid] = __expf(dtv * aneg); }
                        __syncthreads();
                        for (int t = 0; t < tc; ++t) {
                            const float xv = xs[t * 64 + p], dec = decs[t], dtx = dts[t] * xv;
                            float accy = 0.f;
#pragma unroll
                            for (int i4 = 0; i4 < 4; ++i4) { const f32x4 b4 = *(const LAS f32x4*)(Bs + t * 128 + n0 + 4 * i4), c4 = *(const LAS f32x4*)(Cs + t * 128 + n0 + 4 * i4);
#pragma unroll
                                for (int e = 0; e < 4; ++e) { hst[4 * i4 + e] = dec * hst[4 * i4 + e] + dtx * b4[e]; accy += hst[4 * i4 + e] * c4[e]; } }
                            accy += __shfl_xor(accy, 1); accy += __shfl_xor(accy, 2); accy += __shfl_xor(accy, 4);
                            if (ng == 0) ysb[t * 64 + p] = accy + Dsk * xv;
                        }
                        __syncthreads();
                        for (int e = tid; e < tc * 64; e += 512) { const int tok = e >> 6, pp = e & 63; YS[(row0 + t0 + tok) * DM + hd * 64 + pp] = (bf16)f2bf(ysb[e]); }
                    }
                    float* ho = out + (isS ? O_SSSM + ((size_t)(l * 32 + sq) * 16 + hd) * 8192 : O_PSSM + ((size_t)(l * 16 + sq) * 16 + hd) * 8192) + p * 128 + n0;
#pragma unroll
                    for (int i4 = 0; i4 < 4; ++i4) *(f32x4*)(ho + 4 * i4) = (f32x4){hst[4 * i4], hst[4 * i4 + 1], hst[4 * i4 + 2], hst[4 * i4 + 3]};
                }
                __syncthreads();
            }
        }
        SEAM(pb + 4);
        if (IN(pb + 5)) {
            PH_PTRS PH_LAYER
            if (SUB(pb + 5, 0)) {
                constexpr int LT = 136, AS = 68;
                LAS bf16* Xs = (LAS bf16*)lds;
                LAS bf16* Ws = Xs + 128 * LT;
                LAS float* As = (LAS float*)(Ws + 128 * LT);
                LAS float* Us = As + 128 * AS;
                LAS float* sP = Us + 128 * AS;
                LAS float* sH = sP + 512;
                LAS float* cS = sH + 512;
                LAS float* cst = cS + 128;
                static_assert(2 * 128 * LT * 2 + (2 * 128 * AS + 512 + 512 + 128 + 192) * 4 <= LDSCTL_OFF, "LRU LDS map");
                const int qq = lane & 15, q4 = lane >> 4, w = wave;
                for (int un = vcu; un < 256; un += G) {
                    const int b = un >> 4, j = (un >> 1) & 7, h2 = un & 1, chb = j * 128 + 64 * h2;
                    __syncthreads();
                    { const bf16* wg = (const bf16*)(wl + WL_G);
#pragma unroll
                      for (int k = 0; k < 4; ++k) { const int idx = tid + 512 * k, n = idx >> 4, part = idx & 15; const int srow = j * 256 + (n < 64 ? 64 * h2 + n : 128 + 64 * h2 + (n - 64));
                          *(LAS v4u*)(Ws + n * LT + part * 8) = *(const v4u*)(wg + (size_t)srow * 128 + part * 8); }
                      if (tid < 64) { cst[tid] = A->in[I_BR][l * DM + chb + tid]; cst[64 + tid] = A->in[I_BI][l * DM + chb + tid]; cst[128 + tid] = ((const float*)(ws + WS_SPL))[l * DM + chb + tid]; cS[tid] = 0.f; } }
                    const int cpart = tid & 15, ctb = 4 * (tid >> 4);
                    float cwv[4][8], cbv[8];
#pragma unroll
                    for (int e = 0; e < 8; ++e) { cbv[e] = A->in[I_CCB][l * DM + j * 128 + cpart * 8 + e];
#pragma unroll
                        for (int jj = 0; jj < 4; ++jj) cwv[jj][e] = A->in[I_CCW][(size_t)(l * 4 + jj) * DM + j * 128 + cpart * 8 + e]; }
                    v4u xr[7] = {(v4u){0u, 0u, 0u, 0u}, (v4u){0u, 0u, 0u, 0u}, (v4u){0u, 0u, 0u, 0u}, (v4u){0u, 0u, 0u, 0u}, (v4u){0u, 0u, 0u, 0u}, (v4u){0u, 0u, 0u, 0u}, (v4u){0u, 0u, 0u, 0u}};
#define LRU_LOAD(tile_) do { const int tb_ = 128 * (tile_) + ctb - 3; \
                        _Pragma("unroll") for (int k = 0; k < 7; ++k) { xr[k] = (v4u){0u, 0u, 0u, 0u}; if (tb_ + k >= 0) xr[k] = *(const v4u*)ZP(Z, (size_t)b * SEQ + tb_ + k, ZXC + j * 128 + cpart * 8); } } while (0)
                    LRU_LOAD(0);
#pragma unroll 1
                    for (int tile = 0; tile < 16; ++tile) {
                        const size_t r0 = (size_t)b * SEQ + 128 * tile;
                        LBAR();
                        { float xf7[7][8];
#pragma unroll
                          for (int k = 0; k < 7; ++k) unpack8(xr[k], xf7[k]);
#pragma unroll
                          for (int k = 0; k < 4; ++k) { float o8[8];
#pragma unroll
                              for (int e = 0; e < 8; ++e) o8[e] = cbv[e] + cwv[0][e] * xf7[k][e] + cwv[1][e] * xf7[k + 1][e] + cwv[2][e] * xf7[k + 2][e] + cwv[3][e] * xf7[k + 3][e];
                              *(LAS v4u*)(Xs + (ctb + k) * LT + cpart * 8) = pack8(o8); } }
                        if (tile < 15) LRU_LOAD(tile + 1);
                        v4u gcr[2];
#pragma unroll
                        for (int k = 0; k < 2; ++k) { const int idx = tid + 512 * k, t_ = idx >> 3, part = idx & 7; gcr[k] = *(const v4u*)ZP(Z, r0 + t_, ZGC + chb + part * 8); }
                        LBAR();
                        { bf16x8 xf[4];
#pragma unroll
                          for (int ks = 0; ks < 4; ++ks) xf[ks] = *(const LAS bf16x8*)(Xs + (16 * w + qq) * LT + 32 * ks + 8 * q4);
                          f32x4 ga[8];
#pragma unroll
                          for (int nt = 0; nt < 8; ++nt) { ga[nt] = (f32x4){0.f, 0.f, 0.f, 0.f};
#pragma unroll
                              for (int ks = 0; ks < 4; ++ks) { const bf16x8 wf = *(const LAS bf16x8*)(Ws + (16 * nt + qq) * LT + 32 * ks + 8 * q4); ga[nt] = __builtin_amdgcn_mfma_f32_16x16x32_bf16(wf, xf[ks], ga[nt], 0, 0, 0); } }
#pragma unroll
                          for (int nt = 0; nt < 4; ++nt) { const int c0 = 16 * nt + 4 * q4;
                              const f32x4 brv = *(const LAS f32x4*)(cst + c0), biv = *(const LAS f32x4*)(cst + 64 + c0), spv = *(const LAS f32x4*)(cst + 128 + c0);
                              const v2u xw = *(const LAS v2u*)(Xs + (16 * w + qq) * LT + 64 * h2 + c0); const float xv[4] = {bflo(xw.x), bfhi(xw.x), bflo(xw.y), bfhi(xw.y)};
                              f32x4 av, uv;
#pragma unroll
                              for (int i = 0; i < 4; ++i) { const float rg = sigmoidf_(ga[nt][i] + brv[i]), ig = sigmoidf_(ga[nt + 4][i] + biv[i]); const float la = spv[i] * rg;
                                  av[i] = __expf(la); uv[i] = xv[i] * ig * __builtin_amdgcn_sqrtf(one_minus_exp(2.f * la)); }
                              *(LAS f32x4*)(As + (16 * w + qq) * AS + c0) = av; *(LAS f32x4*)(Us + (16 * w + qq) * AS + c0) = uv; } }
                        LBAR();
                        const int ch = tid & 63, sg = tid >> 6;
                        float pa[16], ph[16];
#pragma unroll
                        for (int t = 0; t < 16; ++t) { const int o = (16 * sg + t) * AS + ch; pa[t] = As[o]; ph[t] = Us[o]; }
                        { float P = 1.f, Hh = 0.f;
#pragma unroll
                          for (int t = 0; t < 16; ++t) { Hh = pa[t] * Hh + ph[t]; P *= pa[t]; pa[t] = P; ph[t] = Hh; }
                          sP[sg * 64 + ch] = P; sH[sg * 64 + ch] = Hh; }
                        LBAR();
                        { float c = cS[(tile & 1) * 64 + ch];
                          for (int s2 = 0; s2 < sg; ++s2) c = sP[s2 * 64 + ch] * c + sH[s2 * 64 + ch];
#pragma unroll
                          for (int t = 0; t < 16; ++t) Us[(16 * sg + t) * AS + ch] = ph[t] + pa[t] * c;
                          if (sg == 7) cS[((tile + 1) & 1) * 64 + ch] = sP[7 * 64 + ch] * c + sH[7 * 64 + ch]; }
                        LBAR();
#pragma unroll
                        for (int k = 0; k < 2; ++k) { const int idx = tid + 512 * k, t_ = idx >> 3, part = idx & 7;
                            const f32x4 h0 = *(const LAS f32x4*)(Us + t_ * AS + part * 8), h1 = *(const LAS f32x4*)(Us + t_ * AS + part * 8 + 4);
                            float gv[8]; unpack8(gcr[k], gv);
                            float o8[8];
#pragma unroll
                            for (int e = 0; e < 8; ++e) o8[e] = (e < 4 ? h0[e] : h1[e - 4]) * gelu_tanh(gv[e]);
                            *(v4u*)(HCG + (r0 + t_) * DM + chb + part * 8) = pack8(o8); }
                    }
                    __syncthreads();
                    if (tid < 64) out[O_PLRU + (size_t)(l * 16 + b) * DM + chb + tid] = cS[tid];
                }
                __syncthreads();
                for (int i = bx * 512 + tid; i < 32 * DM; i += G * 512) { const int sb = i >> 10, ch = i & 1023; const size_t r0 = (size_t)NPROMPT + sb * 8;
                    float hc = A->in[I_SLRU][(size_t)(l * 32 + sb) * DM + ch];
                    for (int t = 0; t < 8; ++t) { hc = AL[(size_t)(sb * 8 + t) * DM + ch] * hc + U[(size_t)(sb * 8 + t) * DM + ch]; HCG[(r0 + t) * DM + ch] = (bf16)f2bf(hc * gelu_tanh(bf2f(*ZP(Z, r0 + t, ZGC + ch)))); }
                    out[O_SLRU + (size_t)(l * 32 + sb) * DM + ch] = hc; }
            }
            if (SUB(pb + 5, 1))
            for (int row = gw; row < M; row += NGW) {
                const int hh = lane >> 3; const float l0 = LSE[((size_t)0 * M + row) * 8 + hh], l1 = LSE[((size_t)1 * M + row) * 8 + hh], l2 = LSE[((size_t)2 * M + row) * 8 + hh];
                const v4u r0 = *(const v4u*)(OG + ((size_t)0 * M + row) * 512 + 8 * lane), r1 = *(const v4u*)(OG + ((size_t)1 * M + row) * 512 + 8 * lane), r2 = *(const v4u*)(OG + ((size_t)2 * M + row) * 512 + 8 * lane);
                v4u yr[2], zr[2];
#pragma unroll
                for (int q = 0; q < 2; ++q) { const int col = q * 512 + 8 * lane; yr[q] = *(const v4u*)(YS + (size_t)row * DM + col); zr[q] = *(const v4u*)ZP(Z, row, ZZB + col); }
                { const float mx = fmaxf(l0, fmaxf(l1, l2)); const float e0 = __expf(l0 - mx), e1 = __expf(l1 - mx), e2 = __expf(l2 - mx); const float inv = rcpf_(e0 + e1 + e2);
                  float o0[8], o1[8], o2[8]; unpack8(r0, o0); unpack8(r1, o1); unpack8(r2, o2);
                  float o[8];
#pragma unroll
                  for (int e = 0; e < 8; ++e) o[e] = (e0 * o0[e] + e1 * o1[e] + e2 * o2[e]) * inv;
                  *(v4u*)(OA + (size_t)row * DM + 8 * lane) = pack8(o); }
#pragma unroll
                for (int q = 0; q < 2; ++q) { const int col = q * 512 + 8 * lane;
                    float yv[8]; unpack8(yr[q], yv);
                    float zz[8]; unpack8(zr[q], zz);
                    float v[8]; float ss = 0.f;
#pragma unroll
                    for (int e = 0; e < 8; ++e) { v[e] = yv[e] * siluf_(zz[e]); ss += v[e] * v[e]; }
                    const float rs = __builtin_amdgcn_rsqf(wave_sum(ss) * (1.f / 512.f) + EPS);
                    const float* gn = A->in[I_GSSM] + l * DM + col;
#pragma unroll
                    for (int e = 0; e < 8; ++e) v[e] = v[e] * rs * gn[e];
                    *(v4u*)(YN + (size_t)row * DM + col) = pack8(v); }
            }
        }
        SEAM(pb + 5);
        if (IN(pb + 6)) {
            PH_PTRS PH_LAYER
            sample_merge_units(lds, OA, YN, HCG, (const bf16*)(wl + WL_A), (const bf16*)(wl + WL_B), (const bf16*)(wl + WL_C), Z, MG, tid, vcu, G);
            pg8::Seg3Order<pg8::StaticOrder> S; S.b.init(NPROMPT, DM, G, bx);
            pg8::Gemm g{OA, (const bf16*)(wl + WL_A), M, DM, DM, DM, DM, 0, YN, (const bf16*)(wl + WL_B), HCG, (const bf16*)(wl + WL_C), 512};
            pg8::EpiMerge3 E{Z, ACC, MG};
            pg8::gemm_phase<pg8::EpiMerge3, pg8::Seg3Order<pg8::StaticOrder>, true>(lds, g, S, E);
        }
        SEAM(pb + 6);
        if (IN(pb + 7)) {
            PH_PTRS PH_LAYER
            sample_resid_units<DM>(lds, MG, DM, (const bf16*)(wl + WL_O), DM, X, modl + 5 * DM, PSCALE(pb + 7, 1.0f), XB, SSQ, GAM + (size_t)(l * 3 + 2) * NSEQ * DM, tid, vcu, G);
            pg8::Gemm g{MG, (const bf16*)(wl + WL_O), M, DM, DM, DM, DM, 0}; pg8::StaticOrder S; S.init(NPROMPT, DM, G, bx);
            pg8::EpiResid<true> E{X, modl + 5 * DM, PSCALE(pb + 7, 1.0f), XB, SSQ, GAM + (size_t)(l * 3 + 2) * NSEQ * DM};
            pg8::gemm_phase<pg8::EpiResid<true>, pg8::StaticOrder>(lds, g, S, E);
        }
        SEAM(pb + 7);
        if (IN(pb + 8)) {
            PH_PTRS PH_LAYER
            pg8::Gemm g{XB, (const bf16*)(wl + WL_F2I), M, 2 * DFF, DM, DM, DM, 0}; pg8::HalfOrder S; S.init(2 * DFF, G, bx);
            pg8::EpiSwiGLU E{Gb, SSQ, (const float*)(ws + WS_SHW3) + (size_t)l * NSEQ * 2 * DFF};
            pg8::gemm_phase<pg8::EpiSwiGLU, pg8::HalfOrder>(lds, g, S, E);
        }
        SEAM(pb + 8);
        if (IN(pb + 9)) {
            PH_PTRS PH_LAYER
            sample_resid_units<DFF>(lds, Gb, DFF, (const bf16*)(wl + WL_F2O), DFF, X, modl + 8 * DM, PSCALE(pb + 9, 0.5f), XB, SSQ, GAM + (size_t)((l < 1 ? l + 1 : l) * 3 + 0) * NSEQ * DM, tid, vcu, G);
            pg8::Gemm g{Gb, (const bf16*)(wl + WL_F2O), M, DM, DFF, DFF, DFF, 0}; pg8::StaticOrder S; S.init(NPROMPT, DM, G, bx);
            pg8::EpiResid<true> E{X, modl + 8 * DM, PSCALE(pb + 9, 0.5f), XB, SSQ, GAM + (size_t)((l < 1 ? l + 1 : l) * 3 + 0) * NSEQ * DM};
            pg8::gemm_phase<pg8::EpiResid<true>, pg8::StaticOrder>(lds, g, S, E);
        }
        SEAM(pb + 9);
    }
    if (IN(PH_FINAL)) {
        PH_PTRS
        const float* gvec = A->in[I_GFIN];
        f32x4 gv[4];
#pragma unroll
        for (int j = 0; j < 4; ++j) gv[j] = *(const f32x4*)(gvec + 4 * (lane + 64 * j));
        for (int row0 = gw; row0 < M; row0 += 4 * NGW) {
            v2u xw_[4][4];
#pragma unroll
            for (int k = 0; k < 4; ++k) { const int row = row0 + k * NGW;
#pragma unroll
                for (int j = 0; j < 4; ++j) { xw_[k][j] = (v2u){0u, 0u}; if (row < M) xw_[k][j] = *(const v2u*)(X + (size_t)row * DM + 4 * (lane + 64 * j)); } }
#pragma unroll
            for (int k = 0; k < 4; ++k) { const int row = row0 + k * NGW;
                if (row < M) {
                    float* o = out + (row < NPROMPT ? O_YP + (size_t)row * DM : O_YS + (size_t)(row - NPROMPT) * DM);
                    f32x4 v[4]; float ss = 0.f;
#pragma unroll
                    for (int j = 0; j < 4; ++j) { v[j] = (f32x4){bflo(xw_[k][j].x), bfhi(xw_[k][j].x), bflo(xw_[k][j].y), bfhi(xw_[k][j].y)}; ss += (v[j].x * v[j].x + v[j].y * v[j].y) + (v[j].z * v[j].z + v[j].w * v[j].w); }
                    const float rs = __builtin_amdgcn_rsqf(wave_sum(ss) * (1.f / DM) + EPS);
#pragma unroll
                    for (int j = 0; j < 4; ++j) { const int c = 4 * (lane + 64 * j); *(f32x4*)(o + c) = v[j] * rs * gv[j]; } } }
        }
    }
#undef IN
#undef SEAM
}

extern "C" void kernel_launch(void* const* d_in, const int* in_sizes, int n_in, void* d_out, int out_size, void* d_ws, size_t ws_size, hipStream_t stream) {
    static int grid = 0;
    if (grid == 0) {
        if (n_in != N_INPUTS || (size_t)out_size != O_END || ws_size < WS_END) { fprintf(stderr, "kernel_launch: unexpected shapes: n_in %d out %d ws %zu (need %zu)\n", n_in, out_size, ws_size, (size_t)WS_END); grid = -1; return; }
        int dev = 0, cus = 0;
        if (hipGetDevice(&dev) != hipSuccess || hipDeviceGetAttribute(&cus, hipDeviceAttributeMultiprocessorCount, dev) != hipSuccess) { grid = -1; return; }
        if (hipFuncSetAttribute((const void*)fwd, hipFuncAttributeMaxDynamicSharedMemorySize, LDS_BYTES) != hipSuccess) { fprintf(stderr, "kernel_launch: hipFuncSetAttribute failed\n"); grid = -1; return; }
        int per_cu = 0;
        if (hipOccupancyMaxActiveBlocksPerMultiprocessor(&per_cu, (const void*)fwd, NWAVES * 64, LDS_BYTES) != hipSuccess || per_cu < 1) fprintf(stderr, "kernel_launch: occupancy query reports %d\n", per_cu);
        (void)hipGetLastError();
        grid = cus;
    }
    if (grid < 0) return;
    if (hipMemsetAsync((char*)d_ws + WS_CTL, 0, CTL_ZERO_BYTES, stream) != hipSuccess) return;
    Args a{};
    for (int i = 0; i < N_INPUTS; ++i) a.in[i] = (const float*)d_in[i];
    a.out = (float*)d_out; a.ws = (unsigned char*)d_ws; a.li = 0; a.submask = 0xffffffffu; a.pad = 0;
#if defined(PROBE_A)
    a.ph_lo = 0; a.ph_hi = PROBE_B + 1; a.use_bar = 1; a.li = 0;
    hipLaunchKernelGGL(fwd, dim3(grid), dim3(NWAVES * 64), LDS_BYTES, stream, a);
    a.ph_lo = PROBE_A; a.ph_hi = NPHASES; a.use_bar = 1; a.li = 1; a.submask = PROBE_MASK;
    hipLaunchKernelGGL(fwd, dim3(grid), dim3(NWAVES * 64), LDS_BYTES, stream, a);
#elif ONE_LAUNCH
    a.ph_lo = 0; a.ph_hi = NPHASES; a.use_bar = 1;
    hipLaunchKernelGGL(fwd, dim3(grid), dim3(NWAVES * 64), LDS_BYTES, stream, a);
#else
    for (int ph = 0; ph < NPHASES; ++ph) {
        a.ph_lo = ph; a.ph_hi = ph + 1; a.use_bar = 0;
        hipLaunchKernelGGL(fwd, dim3(grid), dim3(NWAVES * 64), LDS_BYTES, stream, a);
    }
#endif
}
```
